# Optimizing an MI355X kernel written in HIP

```python
import jax, jax.numpy as jnp
from jax import lax
import numpy as np

D_MODEL = 1024
BATCH = 8
SEQ = 2048
DEPTH = 2

D_MIX = D_MODEL
RET_HEADS = 8
RET_HEAD_DIM = 64
RET_WIDTH = RET_HEADS * RET_HEAD_DIM
RET_CHUNK = 128
ROPE_BASE = 10000.0
DSA_HEADS = 8
DSA_HEAD_DIM = 64
DSA_WIDTH = DSA_HEADS * DSA_HEAD_DIM
DSA_LATENT = 128
IDX_HEADS = 8
IDX_DIM = 64
IDX_TOPK_MAX = 256
Q_BLOCK = 128
PLE_DIM = 256
D_FF = -(-8 * D_MODEL // (3 * 256)) * 256
EPS = 1e-6
IN_COLS = 4 * RET_WIDTH + DSA_WIDTH + DSA_LATENT + IDX_HEADS * IDX_DIM + IDX_DIM + IDX_HEADS

kernel_name = "hymba_style_retention_dsa_hybrid"


def rms_norm(x, g):
    xf = x.astype(jnp.float32)
    y = xf * lax.rsqrt(jnp.mean(xf * xf, axis=-1, keepdims=True) + EPS)
    return (y * g.astype(jnp.float32)).astype(x.dtype)


def layer_norm(x, g, b):
    xf = x.astype(jnp.float32)
    mu = jnp.mean(xf, axis=-1, keepdims=True)
    var = jnp.mean(jnp.square(xf - mu), axis=-1, keepdims=True)
    y = (xf - mu) * lax.rsqrt(var + EPS)
    return (y * g.astype(jnp.float32) + b.astype(jnp.float32)).astype(x.dtype)


def rotate(x, positions):
    d = x.shape[-1]
    inv_freq = 1.0 / (ROPE_BASE ** (jnp.arange(0, d, 2, dtype=jnp.float32) / d))
    ang = positions.astype(jnp.float32)[:, :, None] * inv_freq
    cos = jnp.cos(ang)[:, :, None, :]
    sin = jnp.sin(ang)[:, :, None, :]
    xf = x.astype(jnp.float32)
    x1, x2 = xf[..., : d // 2], xf[..., d // 2:]
    return jnp.concatenate([x1 * cos - x2 * sin, x1 * sin + x2 * cos], axis=-1)


def retention_chunkwise(q, k, v):
    B, S, H, d = q.shape
    C = RET_CHUNK
    N = S // C
    log_g = jnp.log1p(-jnp.power(2.0, -5.0 - jnp.arange(H, dtype=jnp.float32)))
    q = q.astype(jnp.float32).reshape(B, N, C, H, d)
    k = (k.astype(jnp.float32) * (d ** -0.5)).reshape(B, N, C, H, d)
    v = v.astype(jnp.float32).reshape(B, N, C, H, d)
    i = jnp.arange(C, dtype=jnp.float32)
    diff = i[:, None] - i[None, :]
    decay = jnp.where(diff >= 0, jnp.exp(log_g[:, None, None] * jnp.maximum(diff, 0.0)), 0.0)
    scores = jnp.einsum('bnihd,bnjhd->bnhij', q, k) * decay
    intra = jnp.einsum('bnhij,bnjhe->bnihe', scores, v)
    zeta = jnp.exp(log_g[None, :] * (C - 1 - i)[:, None])
    kv = jnp.einsum('bnjhd,bnjhe->bnhde', k * zeta[None, None, :, :, None], v)
    chunk_decay = jnp.exp(log_g * C)[None, :, None, None]

    def step(R, kv_n):
        return chunk_decay * R + kv_n, R

    _, R_prev = lax.scan(step, jnp.zeros((B, H, d, d), jnp.float32), jnp.moveaxis(kv, 1, 0))
    R_prev = jnp.moveaxis(R_prev, 0, 1)
    xi = jnp.exp(log_g[None, :] * (i + 1.0)[:, None])
    cross = jnp.einsum('bnihd,bnhde->bnihe', q * xi[None, None, :, :, None], R_prev)
    return (intra + cross).reshape(B, S, H, d)


def dsa_sparse_attention(q_lat, c_kv, qi, ki, wi):
    B, S, H, C = q_lat.shape
    NB = S // Q_BLOCK
    topk = min(IDX_TOPK_MAX, S // 4)
    s_idx = jnp.arange(S)
    b_idx = jnp.arange(B)[:, None, None]

    def to_blocks(a):
        return jnp.moveaxis(a.reshape((B, NB, Q_BLOCK) + a.shape[2:]), 1, 0)

    def block(args):
        ql_b, qi_b, wi_b, start = args
        t = start + jnp.arange(Q_BLOCK)
        rel = jax.nn.relu(jnp.einsum('bthd,bsd->bths', qi_b, ki).astype(jnp.float32))
        iscore = jnp.einsum('bths,bth->bts', rel, wi_b.astype(jnp.float32))
        causal = s_idx[None, :] <= t[:, None]
        iscore = jnp.where(causal[None], iscore, -jnp.inf)
        _, sel = lax.top_k(iscore, topk)
        valid = sel <= t[None, :, None]
        kv_sel = c_kv[b_idx, sel]
        logits = jnp.einsum('bthc,btkc->bthk', ql_b, kv_sel).astype(jnp.float32)
        logits = jnp.where(valid[:, :, None, :], logits, -jnp.inf)
        probs = jax.nn.softmax(logits, axis=-1).astype(kv_sel.dtype)
        return jnp.einsum('bthk,btkc->bthc', probs, kv_sel)

    starts = jnp.arange(NB, dtype=jnp.int32) * Q_BLOCK
    o = lax.map(block, (to_blocks(q_lat), to_blocks(qi), to_blocks(wi), starts))
    return jnp.moveaxis(o, 0, 1).reshape(B, S, H, C)


def split_cols(proj):
    sizes = (RET_WIDTH,) * 4 + (DSA_WIDTH, DSA_LATENT, IDX_HEADS * IDX_DIM, IDX_DIM, IDX_HEADS)
    out, o = [], 0
    for sz in sizes:
        out.append(proj[..., o:o + sz])
        o += sz
    return out


def setup_inputs(seed: int = 0) -> dict:
    key = jax.random.key(seed)
    ks = jax.random.split(key, 24)
    f32 = jnp.float32

    def nrm(k, shape, fan_in):
        return jax.random.normal(k, shape, f32) * (fan_in ** -0.5)

    def gain(k, shape):
        return 1.0 + 0.02 * jax.random.normal(k, shape, f32)

    def bias(k, shape):
        return 0.02 * jax.random.normal(k, shape, f32)

    L = DEPTH
    x = jax.random.normal(ks[0], (BATCH, SEQ, D_MODEL), f32)
    p = jax.random.normal(ks[1], (DEPTH, BATCH, SEQ, PLE_DIM), f32)
    offsets = jax.random.randint(ks[2], (BATCH, 1), 0, 1024, dtype=jnp.int32)
    positions = offsets + jnp.arange(SEQ, dtype=jnp.int32)[None, :]
    return {
        "x": x,
        "p": p,
        "positions": positions,
        "pre_mix_g": gain(ks[3], (L, D_MODEL)),
        "w_in": nrm(ks[4], (L, D_MODEL, IN_COLS), D_MODEL),
        "ret_norm_g": gain(ks[5], (L, RET_HEADS, RET_HEAD_DIM)),
        "ret_norm_b": bias(ks[6], (L, RET_HEADS, RET_HEAD_DIM)),
        "kv_norm_g": gain(ks[7], (L, DSA_LATENT)),
        "idx_k_norm_g": gain(ks[8], (L, IDX_DIM)),
        "idx_k_norm_b": bias(ks[9], (L, IDX_DIM)),
        "w_uk": nrm(ks[10], (L, DSA_HEADS, DSA_HEAD_DIM, DSA_LATENT), DSA_HEAD_DIM),
        "w_uv": nrm(ks[11], (L, DSA_HEADS, DSA_LATENT, DSA_HEAD_DIM), DSA_LATENT),
        "w_out": nrm(ks[12], (L, D_MIX, D_MODEL), D_MIX),
        "post_mix_g": gain(ks[13], (L, D_MODEL)),
        "pre_ffn_g": gain(ks[14], (L, D_MODEL)),
        "w_ffn_gate": nrm(ks[15], (L, D_MODEL, D_FF), D_MODEL),
        "w_ffn_up": nrm(ks[16], (L, D_MODEL, D_FF), D_MODEL),
        "w_ffn_down": nrm(ks[17], (L, D_FF, D_MODEL), D_FF),
        "post_ffn_g": gain(ks[18], (L, D_MODEL)),
        "w_ple_up": nrm(ks[19], (L, PLE_DIM, D_MODEL), PLE_DIM),
        "w_ple_gate": nrm(ks[20], (L, D_MODEL, D_MODEL), D_MODEL),
        "ple_norm_g": gain(ks[21], (L, D_MODEL)),
    }


def reference(x, p, positions, pre_mix_g, w_in, ret_norm_g, ret_norm_b, kv_norm_g,
              idx_k_norm_g, idx_k_norm_b, w_uk, w_uv, w_out, post_mix_g, pre_ffn_g,
              w_ffn_gate, w_ffn_up, w_ffn_down, post_ffn_g, w_ple_up, w_ple_gate, ple_norm_g):
    B, S, _ = x.shape
    for i in range(DEPTH):
        h = rms_norm(x, pre_mix_g[i])
        proj = h @ w_in[i]
        r_q, r_k, r_v, r_g, a_q, a_c, i_q, i_k, i_w = split_cols(proj)

        rq = rotate(r_q.reshape(B, S, RET_HEADS, RET_HEAD_DIM), positions)
        rk = rotate(r_k.reshape(B, S, RET_HEADS, RET_HEAD_DIM), positions)
        rv = r_v.reshape(B, S, RET_HEADS, RET_HEAD_DIM)
        ry = retention_chunkwise(rq, rk, rv).astype(x.dtype)
        ry = layer_norm(ry, ret_norm_g[i], ret_norm_b[i]).reshape(B, S, RET_WIDTH)
        y_ret = jax.nn.silu(r_g) * ry

        aq = a_q.reshape(B, S, DSA_HEADS, DSA_HEAD_DIM)
        c_kv = rms_norm(a_c, kv_norm_g[i])
        q_lat = jnp.einsum('bshd,hdc->bshc', aq, w_uk[i]) * (DSA_HEAD_DIM ** -0.5)
        qi = i_q.reshape(B, S, IDX_HEADS, IDX_DIM)
        ki = layer_norm(i_k, idx_k_norm_g[i], idx_k_norm_b[i])
        wi = i_w * ((IDX_HEADS ** -0.5) * (IDX_DIM ** -0.5))
        o_lat = dsa_sparse_attention(q_lat, c_kv, qi, ki, wi)
        y_dsa = jnp.einsum('bshc,hcd->bshd', o_lat, w_uv[i]).reshape(B, S, DSA_WIDTH)

        mix = jnp.concatenate([y_ret, y_dsa], axis=-1) @ w_out[i]
        x = x + rms_norm(mix, post_mix_g[i])

        f = rms_norm(x, pre_ffn_g[i])
        f = (jax.nn.silu(f @ w_ffn_gate[i]) * (f @ w_ffn_up[i])) @ w_ffn_down[i]
        x = x + rms_norm(f, post_ffn_g[i])

        e = p[i] @ w_ple_up[i]
        gate = jax.nn.sigmoid(x @ w_ple_gate[i])
        x = x + rms_norm(gate * e, ple_norm_g[i])
    return x
```

```cpp
#include <hip/hip_runtime.h>
#include <cstdio>
#include <cstdint>
#include <cmath>

#ifndef MK_PER_PHASE
#define MK_PER_PHASE 0
#endif

namespace pg8 {
#define PG8_LAS __attribute__((address_space(3)))
typedef unsigned short bf16_t;
typedef short bf16x8 __attribute__((ext_vector_type(8)));
typedef float f32x4 __attribute__((ext_vector_type(4)));
typedef unsigned u32x4 __attribute__((ext_vector_type(4)));
typedef unsigned u32x2 __attribute__((ext_vector_type(2)));
constexpr int BM = 256, BK = 64, HALF = 128, HTB = HALF * BK * 2, STAGE_BYTES = 8 * HTB, NXCD = 8, WGM = 8;

__host__ __device__ __forceinline__ int lds_byte(int r, int c) { const int st = (r >> 4) * 2 + (c >> 5), rr = r & 15, cc = c & 31, ob = rr * 64 + cc * 2; return st * 1024 + (ob ^ (((ob >> 9) & 1) << 5)); }
__host__ __device__ __forceinline__ void stage_rc(int b, int& R, int& C) { const int st = b / 1024, sb = b % 1024, swz = sb ^ (((sb >> 9) & 1) << 5); R = (st >> 1) * 16 + swz / 64; C = (st & 1) * 32 + (swz % 64) / 2; }
__host__ __device__ __forceinline__ int perm32(int rho) { const int n = rho >> 4, i = rho & 15; return 8 * (i >> 2) + 4 * n + (i & 3); }

struct Unit { int pm, pn; };
struct Gemm { const bf16_t* A; const bf16_t* Bt; int M, N, K; };

struct StaticOrder {
    int nM, nN, nwg, G, c;
    __host__ __device__ void init(int M, int N, int G_, int c_) { nM = M / BM; nN = N / BM; nwg = nM * nN; G = G_; c = c_; }
    __host__ __device__ bool next(int i, Unit& u) const {
        const long L = (long)i * G + c; if (L >= nwg) return false;
        int wgid = (int)L; { const int q = nwg / NXCD, r = nwg % NXCD, xcd = wgid % NXCD, off = wgid / NXCD; wgid = (xcd < r ? xcd * (q + 1) : r * (q + 1) + (xcd - r) * q) + off; }
        const int nig = WGM * nN, gid = wgid / nig, fm = gid * WGM, gsz = (nM - fm) < WGM ? (nM - fm) : WGM;
        u.pm = fm + ((wgid % nig) % gsz); u.pn = (wgid % nig) / gsz; return true;
    }
    __device__ __forceinline__ void a_ready(const Unit&) const {}
    __device__ __forceinline__ void done(const Unit&) const {}
};

__device__ __forceinline__ unsigned cvt_pk_bf16(float lo, float hi) { unsigned r; asm volatile("v_cvt_pk_bf16_f32 %0, %1, %2" : "=v"(r) : "v"(lo), "v"(hi)); return r; }
__device__ __forceinline__ float silu_f(float x) { return x / (1.f + __expf(-x)); }
__device__ __forceinline__ float sigmoid_f(float x) { return 1.f / (1.f + __expf(-x)); }
__device__ __forceinline__ float bf_lo(unsigned w) { return __uint_as_float(w << 16); }
__device__ __forceinline__ float bf_hi(unsigned w) { return __uint_as_float(w & 0xffff0000u); }


struct EpiInProj {
    static constexpr bool PERM = true, AFTER_DRAIN = false;
    bf16_t* proj; float* misc; const float* cosT; const float* sinT; int Mrows;
    __device__ __forceinline__ void operator()(const f32x4 (&acc)[2][2][4][2], const Unit& u, int wr, int wc, int fr, int fq) const {
        const int row0 = u.pm * BM + wr * 64 + fr;
        if (u.pn == 12) {
#pragma unroll
            for (int ai = 0; ai < 2; ++ai)
#pragma unroll
                for (int m = 0; m < 4; ++m) { float* rowp = misc + (size_t)(row0 + ai * HALF + m * 16) * 256 + wc * 32 + 8 * fq;
#pragma unroll
                    for (int bj = 0; bj < 2; ++bj) { *(f32x4*)(rowp + bj * HALF) = acc[ai][bj][m][0]; *(f32x4*)(rowp + bj * HALF + 4) = acc[ai][bj][m][1]; } }
            return;
        }
        const int t = u.pn >> 1, colt = (u.pn & 1) * 256 + wc * 32 + 8 * fq;
        bf16_t* base = proj + (size_t)t * Mrows * 512;
        const int u8 = ((wc & 1) * 4 + fq);
#pragma unroll
        for (int ai = 0; ai < 2; ++ai)
#pragma unroll
            for (int m = 0; m < 4; ++m) { const int row = row0 + ai * HALF + m * 16; bf16_t* rowp = base + (size_t)row * 512 + colt;
                f32x4 cs = {1.f, 1.f, 1.f, 1.f}, sn = {0.f, 0.f, 0.f, 0.f};
                if (t <= 1) { cs = *(const f32x4*)(cosT + (size_t)row * 32 + 4 * u8); sn = *(const f32x4*)(sinT + (size_t)row * 32 + 4 * u8); }
#pragma unroll
                for (int bj = 0; bj < 2; ++bj) { f32x4 v0 = acc[ai][bj][m][0], v1 = acc[ai][bj][m][1];
                    if (t <= 1) { const f32x4 o0 = v0 * cs - v1 * sn, o1 = v0 * sn + v1 * cs; v0 = o0; v1 = o1; if (t == 1) { v0 = v0 * 0.125f; v1 = v1 * 0.125f; } }
                    else if (t == 3) {
#pragma unroll
                        for (int i = 0; i < 4; ++i) { v0[i] = silu_f(v0[i]); v1[i] = silu_f(v1[i]); } }
                    u32x4 w; w.x = cvt_pk_bf16(v0[0], v0[1]); w.y = cvt_pk_bf16(v0[2], v0[3]); w.z = cvt_pk_bf16(v1[0], v1[1]); w.w = cvt_pk_bf16(v1[2], v1[3]);
                    *(u32x4*)(rowp + bj * HALF) = w; } }
    }
};
struct EpiF32 {
    static constexpr bool PERM = false, AFTER_DRAIN = false;
    float* C; int ldc;
    __device__ __forceinline__ void operator()(const f32x4 (&acc)[2][2][4][2], const Unit& u, int wr, int wc, int fr, int fq) const {
        const int row0 = u.pm * BM + wr * 64 + fr, col0 = u.pn * BM + wc * 32 + 4 * fq;
#pragma unroll
        for (int ai = 0; ai < 2; ++ai)
#pragma unroll
            for (int m = 0; m < 4; ++m) { float* rowp = C + (size_t)(row0 + ai * HALF + m * 16) * ldc + col0;
#pragma unroll
                for (int bj = 0; bj < 2; ++bj)
#pragma unroll
                    for (int n = 0; n < 2; ++n) *(f32x4*)(rowp + bj * HALF + n * 16) = acc[ai][bj][m][n]; }
    }
};
struct EpiSwiGLU {
    static constexpr bool PERM = true, AFTER_DRAIN = false;
    bf16_t* O; int ldo;
    __device__ __forceinline__ void operator()(const f32x4 (&acc)[2][2][4][2], const Unit& u, int wr, int wc, int fr, int fq) const {
        const int row0 = u.pm * BM + wr * 64 + fr, hcol0 = u.pn * 128 + wc * 16 + 4 * fq;
#pragma unroll
        for (int ai = 0; ai < 2; ++ai)
#pragma unroll
            for (int m = 0; m < 4; ++m) { bf16_t* rowp = O + (size_t)(row0 + ai * HALF + m * 16) * ldo + hcol0;
#pragma unroll
                for (int bj = 0; bj < 2; ++bj) { const f32x4 g = acc[ai][bj][m][0], up = acc[ai][bj][m][1]; f32x4 o;
#pragma unroll
                    for (int i = 0; i < 4; ++i) o[i] = silu_f(g[i]) * up[i];
                    u32x2 w; w.x = cvt_pk_bf16(o[0], o[1]); w.y = cvt_pk_bf16(o[2], o[3]);
                    *(u32x2*)(rowp + bj * 64) = w; } }
    }
};
struct EpiBf16Plain {
    static constexpr bool PERM = true, AFTER_DRAIN = false;
    bf16_t* O; int ldo;
    __device__ __forceinline__ void operator()(const f32x4 (&acc)[2][2][4][2], const Unit& u, int wr, int wc, int fr, int fq) const {
        const int row0 = u.pm * BM + wr * 64 + fr, col0 = u.pn * BM + wc * 32 + 8 * fq;
#pragma unroll
        for (int ai = 0; ai < 2; ++ai)
#pragma unroll
            for (int m = 0; m < 4; ++m) { bf16_t* rowp = O + (size_t)(row0 + ai * HALF + m * 16) * ldo + col0;
#pragma unroll
                for (int bj = 0; bj < 2; ++bj) { const f32x4 v0 = acc[ai][bj][m][0], v1 = acc[ai][bj][m][1];
                    u32x4 w; w.x = cvt_pk_bf16(v0[0], v0[1]); w.y = cvt_pk_bf16(v0[2], v0[3]); w.z = cvt_pk_bf16(v1[0], v1[1]); w.w = cvt_pk_bf16(v1[2], v1[3]);
                    *(u32x4*)(rowp + bj * HALF) = w; } }
    }
};
struct EpiGateMul {
    static constexpr bool PERM = true, AFTER_DRAIN = false;
    const bf16_t* E; float* C; int ldc;
    __device__ __forceinline__ void operator()(const f32x4 (&acc)[2][2][4][2], const Unit& u, int wr, int wc, int fr, int fq) const {
        const int row0 = u.pm * BM + wr * 64 + fr, col0 = u.pn * BM + wc * 32 + 8 * fq;
#pragma unroll
        for (int ai = 0; ai < 2; ++ai)
#pragma unroll
            for (int m = 0; m < 4; ++m) { const size_t off = (size_t)(row0 + ai * HALF + m * 16) * ldc + col0;
#pragma unroll
                for (int bj = 0; bj < 2; ++bj) { const u32x4 e = *(const u32x4*)(E + off + bj * HALF); const f32x4 v0 = acc[ai][bj][m][0], v1 = acc[ai][bj][m][1]; f32x4 o0, o1;
                    o0[0] = sigmoid_f(v0[0]) * bf_lo(e.x); o0[1] = sigmoid_f(v0[1]) * bf_hi(e.x); o0[2] = sigmoid_f(v0[2]) * bf_lo(e.y); o0[3] = sigmoid_f(v0[3]) * bf_hi(e.y);
                    o1[0] = sigmoid_f(v1[0]) * bf_lo(e.z); o1[1] = sigmoid_f(v1[1]) * bf_hi(e.z); o1[2] = sigmoid_f(v1[2]) * bf_lo(e.w); o1[3] = sigmoid_f(v1[3]) * bf_hi(e.w);
                    *(f32x4*)(C + off + bj * HALF) = o0; *(f32x4*)(C + off + bj * HALF + 4) = o1; }
                asm volatile("" ::: "memory"); }
    }
};

template <class Epi, class Sched, bool ALIGN_EPI = false, bool SP2 = false>
__device__ __forceinline__ void gemm_phase(PG8_LAS unsigned char* lds, const Gemm g, const Sched& S, const Epi& E) {
    const int tid = threadIdx.x, wid = __builtin_amdgcn_readfirstlane(tid >> 6), lane = tid & 63, wr = wid >> 2, wc = wid & 3, fr = lane & 15, fq = lane >> 4;
    const int K = g.K, nt = K / BK;
    unsigned voffA[2], voffB[2];
#pragma unroll
    for (int i = 0; i < 2; ++i) { int R, C; stage_rc(tid * 16 + i * 8192, R, C); const int Rb = Epi::PERM ? ((R & ~31) + perm32(R & 31)) : R;
        voffA[i] = (unsigned)(R * K + C) * 2u; voffB[i] = (unsigned)(Rb * K + C) * 2u; }
    const size_t kstep = (size_t)(BK * 2);
    const size_t hstep = (size_t)HALF * K * 2;
    const size_t tstep = 2 * hstep;
    const unsigned ldsw = (unsigned)wid * 1024u;
    const int aoff = lds_byte(wr * 64 + fr, fq * 8), boff = lds_byte(wc * 32 + fr, fq * 8);
#define PG8_SA(b, h) (((b) * 2 + (h)) * HTB)
#define PG8_SB(b, h) ((4 + (b) * 2 + (h)) * HTB)
#define PG8_STAGE(bufoff, gbase, voff) do { _Pragma("unroll") for (int _i = 0; _i < 2; ++_i) \
        __builtin_amdgcn_global_load_lds((const unsigned*)((const char*)(gbase) + (voff)[_i]), (PG8_LAS unsigned*)(lds + (bufoff) + ldsw + _i * 8192), 16, 0, 0); } while (0)
#define PG8_LDA(dst, b, h) do { _Pragma("unroll") for (int m = 0; m < 4; ++m) _Pragma("unroll") for (int k = 0; k < 2; ++k) dst[m][k] = *(const PG8_LAS bf16x8*)(lds + PG8_SA(b, h) + aoff + m * 2048 + k * 1024); } while (0)
#define PG8_LDB(dst, b, h) do { _Pragma("unroll") for (int n = 0; n < 2; ++n) _Pragma("unroll") for (int k = 0; k < 2; ++k) dst[n][k] = *(const PG8_LAS bf16x8*)(lds + PG8_SB(b, h) + boff + n * 2048 + k * 1024); } while (0)
#define PG8_MMA(ai, bj, At, Bt) do { __builtin_amdgcn_s_setprio(1); _Pragma("unroll") for (int m = 0; m < 4; ++m) _Pragma("unroll") for (int n = 0; n < 2; ++n) _Pragma("unroll") for (int k = 0; k < 2; ++k) \
        acc[ai][bj][m][n] = __builtin_amdgcn_mfma_f32_16x16x32_bf16(Bt[n][k], At[m][k], acc[ai][bj][m][n], 0, 0, 0); __builtin_amdgcn_s_setprio(0); } while (0)
#define PG8_WAIT_V(n) asm volatile("s_waitcnt vmcnt(" #n ")" ::: "memory")
#define PG8_WAIT_L(n) asm volatile("s_waitcnt lgkmcnt(" #n ")" ::: "memory")
#define PG8_BAR __builtin_amdgcn_s_barrier()
#define PG8_SCHED __builtin_amdgcn_sched_barrier(0)
    Unit cur, nxt; int ui = 0;
    if (!S.next(0, cur)) return;
    f32x4 acc[2][2][4][2];
#pragma unroll
    for (int a = 0; a < 2; ++a)
#pragma unroll
        for (int b = 0; b < 2; ++b)
#pragma unroll
            for (int m = 0; m < 4; ++m)
#pragma unroll
                for (int n = 0; n < 2; ++n) acc[a][b][m][n] = (f32x4){0.f, 0.f, 0.f, 0.f};
    bf16x8 At[4][2], B0[2][2], B1[2][2];
    const char* cA = (const char*)g.A + (size_t)cur.pm * tstep; const char* cB = (const char*)g.Bt + (size_t)cur.pn * tstep;
    S.a_ready(cur);
    if constexpr (SP2) {
        PG8_STAGE(PG8_SB(0, 0), cB, voffB); PG8_STAGE(PG8_SB(0, 1), cB + hstep, voffB); PG8_STAGE(PG8_SA(0, 0), cA, voffA); PG8_STAGE(PG8_SA(0, 1), cA + hstep, voffA);
        if (wr == 1) PG8_BAR;
        PG8_WAIT_V(2); PG8_BAR;
        PG8_STAGE(PG8_SB(1, 0), cB + kstep, voffB); PG8_STAGE(PG8_SA(1, 0), cA + kstep, voffA); PG8_STAGE(PG8_SB(1, 1), cB + hstep + kstep, voffB);
        PG8_WAIT_V(6); PG8_BAR;
    } else {
        PG8_STAGE(PG8_SB(0, 0), cB, voffB); PG8_STAGE(PG8_SA(0, 0), cA, voffA); PG8_STAGE(PG8_SB(0, 1), cB + hstep, voffB); PG8_STAGE(PG8_SA(0, 1), cA + hstep, voffA);
        if (wr == 1) PG8_BAR;
        PG8_WAIT_V(4); PG8_BAR;
        PG8_STAGE(PG8_SB(1, 0), cB + kstep, voffB); PG8_STAGE(PG8_SA(1, 0), cA + kstep, voffA); PG8_STAGE(PG8_SB(1, 1), cB + hstep + kstep, voffB);
        PG8_WAIT_V(6); PG8_BAR;
    }
    for (;;) {
        const bool has_next = S.next(ui + 1, nxt);
        const char* nA = has_next ? (const char*)g.A + (size_t)nxt.pm * tstep : cA; const char* nB = has_next ? (const char*)g.Bt + (size_t)nxt.pn * tstep : cB;
        for (int t = 0; t < nt; t += 2) {
            const bool last = (t == nt - 2);
            const char* a1 = cA + (size_t)(t + 1) * kstep;
            const char* a2 = last ? nA : cA + (size_t)(t + 2) * kstep; const char* b2 = last ? nB : cB + (size_t)(t + 2) * kstep;
            const char* a3 = a2 + kstep; const char* b3 = b2 + kstep;
            if (last && has_next) S.a_ready(nxt);
            if constexpr (SP2) {
            PG8_LDB(B0, 0, 0); PG8_LDB(B1, 0, 1); PG8_SCHED; PG8_LDA(At, 0, 0); PG8_STAGE(PG8_SA(1, 1), a1 + hstep, voffA);
            PG8_WAIT_V(8); PG8_WAIT_L(0); PG8_BAR; PG8_MMA(0, 0, At, B0); PG8_MMA(0, 1, At, B1); PG8_BAR; PG8_SCHED;
            PG8_LDA(At, 0, 1); PG8_STAGE(PG8_SB(0, 0), b2, voffB); PG8_STAGE(PG8_SB(0, 1), b2 + hstep, voffB); PG8_STAGE(PG8_SA(0, 0), a2, voffA);
            PG8_WAIT_V(8); PG8_WAIT_L(0); PG8_BAR; PG8_MMA(1, 0, At, B0); PG8_MMA(1, 1, At, B1); PG8_BAR; PG8_SCHED;
            PG8_LDB(B0, 1, 0); PG8_LDB(B1, 1, 1); PG8_SCHED; PG8_LDA(At, 1, 0); PG8_STAGE(PG8_SA(0, 1), a2 + hstep, voffA);
            PG8_WAIT_V(8); PG8_WAIT_L(0); PG8_BAR; PG8_MMA(0, 0, At, B0); PG8_MMA(0, 1, At, B1); PG8_BAR; PG8_SCHED;
            PG8_LDA(At, 1, 1); PG8_STAGE(PG8_SB(1, 0), b3, voffB); PG8_STAGE(PG8_SB(1, 1), b3 + hstep, voffB); PG8_STAGE(PG8_SA(1, 0), a3, voffA);
            PG8_WAIT_V(8); PG8_WAIT_L(0); PG8_BAR; PG8_MMA(1, 0, At, B0); PG8_MMA(1, 1, At, B1); PG8_BAR; PG8_SCHED;
            } else {
            PG8_LDB(B0, 0, 0); PG8_SCHED; PG8_LDA(At, 0, 0); PG8_STAGE(PG8_SA(1, 1), a1 + hstep, voffA);
            PG8_WAIT_L(8); PG8_BAR; PG8_WAIT_L(0); PG8_MMA(0, 0, At, B0); PG8_BAR; PG8_SCHED;
            PG8_LDB(B1, 0, 1); PG8_STAGE(PG8_SB(0, 0), b2, voffB);
            PG8_BAR; PG8_WAIT_L(0); PG8_MMA(0, 1, At, B1); PG8_BAR;
            PG8_LDA(At, 0, 1); PG8_STAGE(PG8_SA(0, 0), a2, voffA);
            PG8_BAR; PG8_WAIT_L(0); PG8_MMA(1, 0, At, B0); PG8_BAR; PG8_SCHED;
            PG8_STAGE(PG8_SB(0, 1), b2 + hstep, voffB);
            PG8_WAIT_V(6); PG8_BAR; PG8_MMA(1, 1, At, B1); PG8_BAR;
            PG8_LDB(B0, 1, 0); PG8_SCHED; PG8_LDA(At, 1, 0); PG8_STAGE(PG8_SA(0, 1), a2 + hstep, voffA);
            PG8_WAIT_L(8); PG8_BAR; PG8_WAIT_L(0); PG8_MMA(0, 0, At, B0); PG8_BAR; PG8_SCHED;
            PG8_LDB(B1, 1, 1); PG8_STAGE(PG8_SB(1, 0), b3, voffB);
            PG8_BAR; PG8_WAIT_L(0); PG8_MMA(0, 1, At, B1); PG8_BAR;
            PG8_LDA(At, 1, 1); PG8_STAGE(PG8_SA(1, 0), a3, voffA);
            PG8_BAR; PG8_WAIT_L(0); PG8_MMA(1, 0, At, B0); PG8_BAR; PG8_SCHED;
            PG8_STAGE(PG8_SB(1, 1), b3 + hstep, voffB);
            PG8_WAIT_V(6); PG8_BAR; PG8_MMA(1, 1, At, B1); PG8_BAR;
            }
        }
        if constexpr (ALIGN_EPI) { if (wr == 0) PG8_BAR; }
        if constexpr (!Epi::AFTER_DRAIN) { E(acc, cur, wr, wc, fr, fq); S.done(cur); }
        if (!has_next) break;
#pragma unroll
        for (int a = 0; a < 2; ++a)
#pragma unroll
            for (int b = 0; b < 2; ++b)
#pragma unroll
                for (int m = 0; m < 4; ++m)
#pragma unroll
                    for (int n = 0; n < 2; ++n) acc[a][b][m][n] = (f32x4){0.f, 0.f, 0.f, 0.f};
        cur = nxt; cA = nA; cB = nB; ++ui;
        if constexpr (ALIGN_EPI) { if (wr == 1) PG8_BAR; }
    }
    PG8_WAIT_V(0);
    if constexpr (!ALIGN_EPI) { if (wr == 0) PG8_BAR; }
    PG8_BAR;
    if constexpr (Epi::AFTER_DRAIN) { E.fused(acc, cur, wr, wc, fr, fq, lds, wid, lane); S.done(cur); }
#undef PG8_SA
#undef PG8_SB
#undef PG8_STAGE
#undef PG8_LDA
#undef PG8_LDB
#undef PG8_MMA
#undef PG8_WAIT_V
#undef PG8_WAIT_L
#undef PG8_BAR
#undef PG8_SCHED
}
}

constexpr int NWAVES = 8, NTHREADS = 512;
constexpr int BATCH = 8, SEQ = 2048, DM = 1024, M = BATCH * SEQ, DEPTH = 2;
constexpr int NIN = 3272, NINP = 3328, DFF = 2816, PLE = 256, NGU = 2 * DFF;
constexpr float EPS = 1e-6f;
constexpr int PH_PER_LAYER = 10, NPH = 1 + DEPTH * PH_PER_LAYER;

constexpr size_t MiB = 1u << 20;
constexpr size_t WS_CTL = 0, CTL_ZERO_BYTES = 1 * MiB;
constexpr size_t WS_WIN = 1 * MiB, WS_WOUT = 14 * MiB, WS_WGU = 18 * MiB, WS_WD = 40 * MiB, WS_WPU = 51 * MiB, WS_WPG = 52 * MiB, WS_WUK = 56 * MiB, WS_WUV = 56 * MiB + 512 * 1024;
constexpr size_t WS_PB = 57 * MiB, WS_COS = 73 * MiB, WS_SIN = 75 * MiB;
constexpr size_t WS_PROJ = 80 * MiB;
constexpr size_t WS_HFF = 80 * MiB, WS_TMPD = 80 * MiB, WS_XB = 80 * MiB, WS_TMPG = 112 * MiB;
constexpr size_t WS_ACT = 176 * MiB;
constexpr size_t WS_CKV = 176 * MiB, WS_KI = 180 * MiB, WS_WI = 182 * MiB, WS_RST = 184 * MiB, WS_KV = 192 * MiB;
constexpr size_t WS_CAT = 208 * MiB, WS_EB = 208 * MiB;
constexpr size_t WS_TMPF = 176 * MiB;
constexpr size_t WS_MISC = 240 * MiB, WS_END = 256 * MiB;
static_assert(WS_WIN + (size_t)DEPTH * NINP * DM * 2 <= WS_WOUT && WS_WGU + (size_t)DEPTH * NGU * DM * 2 <= WS_WD && WS_WD + (size_t)DEPTH * DM * DFF * 2 <= WS_WPU, "ws map");
static_assert(WS_PROJ + (size_t)6 * M * 512 * 2 <= WS_ACT && WS_HFF + (size_t)M * DFF * 2 <= WS_ACT && WS_MISC + (size_t)M * 256 * 4 <= WS_END, "ws map");
constexpr int CW_BAR = 4096;

constexpr int RING_OFF = 0, RING_BYTES = 131072;
constexpr int LDSCTL_OFF = RING_BYTES, MISC_OFF = LDSCTL_OFF + 320;
constexpr int LDS_BYTES = 147456;

#define GAS __attribute__((address_space(1)))
#define LAS __attribute__((address_space(3)))
typedef unsigned short bf16;
typedef unsigned v4u __attribute__((ext_vector_type(4)));
typedef unsigned v2u __attribute__((ext_vector_type(2)));
typedef float f32x4 __attribute__((ext_vector_type(4)));
typedef short bf16x8 __attribute__((ext_vector_type(8)));
typedef GAS unsigned gu32;
#define RLX_AGENT __ATOMIC_RELAXED, __HIP_MEMORY_SCOPE_AGENT
#define LDS_WAIT() asm volatile("s_waitcnt lgkmcnt(0)" ::: "memory")
#define VM_WAIT() asm volatile("s_waitcnt vmcnt(0)" ::: "memory")
__device__ __forceinline__ unsigned f2bf(float f) { unsigned u = __builtin_bit_cast(unsigned, f); return (u + 0x7fffu + ((u >> 16) & 1u)) >> 16; }
__device__ __forceinline__ unsigned pk2(float lo, float hi) { return f2bf(lo) | (f2bf(hi) << 16); }
using pg8::bf_lo; using pg8::bf_hi;

#define XB_TMO      128
#define XB_XCNT(j)  (256  + 64 * (j))
#define XB_XSUB(j)  (1280 + 64 * (j))
#define XB_XGEN(j)  (2304 + 64 * (j))
#define XB_TOP      3328
#define XB_TOPGEN   3392
#define XCD_BAR_WORDS 3456
#define XB_SPIN_CAP (1u << 18)

__device__ __forceinline__ unsigned xb_ld(unsigned* p)              { return __hip_atomic_load(p, __ATOMIC_RELAXED, __HIP_MEMORY_SCOPE_AGENT); }
__device__ __forceinline__ unsigned xb_add(unsigned* p, unsigned v) { return __hip_atomic_fetch_add(p, v, __ATOMIC_RELAXED, __HIP_MEMORY_SCOPE_AGENT); }
__device__ __forceinline__ unsigned xb_xcc_id() { return (unsigned)__builtin_amdgcn_s_getreg((3 << 11) | 20) & 0xFu; }
#define XB_SPIN(cond, bar) do { unsigned _sp = 0; while (cond) { __builtin_amdgcn_s_sleep(1); \
    if ((++_sp & 255u) == 0u) { if (xb_ld(&(bar)[XB_TMO])) break; if (_sp > XB_SPIN_CAP) { atomicAdd(&(bar)[XB_TMO], 1u); break; } } } } while (0)

struct XcdBarrier {
    unsigned* bar; unsigned x;
    volatile LAS unsigned* st;
};

__device__ __forceinline__ XcdBarrier xcd_barrier_post(unsigned* bar, volatile LAS unsigned* st) {
    XcdBarrier b; b.bar = bar; b.x = xb_xcc_id(); b.st = st;
    if (threadIdx.x == 0) (void)xb_add(&bar[XB_XCNT(b.x)], 1u);
    return b;
}
__device__ __forceinline__ void xcd_barrier_complete(unsigned* bar, unsigned x, unsigned& nloc, unsigned& nx) {
    const unsigned G = gridDim.x * gridDim.y * gridDim.z;
    unsigned sum, cnt, mine, sp = 0u;
    for (;;) {
        sum = 0u; cnt = 0u; mine = 0u;
#pragma unroll
        for (unsigned j = 0; j < 16; ++j) { const unsigned c = xb_ld(&bar[XB_XCNT(j)]); sum += c; cnt += (c > 0u) ? 1u : 0u; mine = (j == x) ? c : mine; }
        if (sum == G) break;
        __builtin_amdgcn_s_sleep(1);
        if ((++sp & 255u) == 0u) { if (xb_ld(&bar[XB_TMO])) break; if (sp > XB_SPIN_CAP) { atomicAdd(&bar[XB_TMO], 1u); break; } }
    }
    nloc = mine > 0u ? mine : 1u; nx = cnt > 0u ? cnt : 1u;
}

__device__ __forceinline__ void xcd_barrier(const XcdBarrier& b) {
    asm volatile("s_waitcnt vmcnt(0)" ::: "memory");
    __syncthreads();
    if (threadIdx.x == 0) {
        unsigned* bar = b.bar;
        __builtin_amdgcn_s_waitcnt(0);
        unsigned nloc = b.st[0], nx = b.st[1];
        if (nloc == 0u) { xcd_barrier_complete(bar, b.x, nloc, nx); b.st[0] = nloc; b.st[1] = nx; }
        const unsigned old = xb_add(&bar[XB_XSUB(b.x)], 1u);
        const unsigned gen = old / nloc;
        if (old + 1u == (gen + 1u) * nloc) {
            __builtin_amdgcn_fence(__ATOMIC_RELEASE, "agent");
            asm volatile("s_waitcnt vmcnt(0)" ::: "memory");
            const unsigned og = xb_add(&bar[XB_TOP], 1u);
            const unsigned tg = og / nx;
            if (og + 1u == (tg + 1u) * nx) xb_add(&bar[XB_TOPGEN], 1u);
            else XB_SPIN(xb_ld(&bar[XB_TOPGEN]) == tg, bar);
            __builtin_amdgcn_fence(__ATOMIC_ACQUIRE, "agent");
            xb_add(&bar[XB_XGEN(b.x)], 1u);
            asm volatile("s_waitcnt vmcnt(0)" ::: "memory");
        } else {
            XB_SPIN(xb_ld(&bar[XB_XGEN(b.x)]) == gen, bar);
            __builtin_amdgcn_fence(__ATOMIC_ACQUIRE, "agent");
            asm volatile("s_waitcnt vmcnt(0)" ::: "memory");
        }
    }
    __syncthreads();
}

struct Frame {
    LAS unsigned char* lds;
    volatile LAS unsigned* MISC;
    gu32* ctl;
    int tid, lane, wave, G;
    float* out; unsigned char* ws;
};
struct Args { const void* in[22]; float* out; unsigned char* ws; int ph_lo, ph_hi; };
#define INP(k) ((const float*)A.in[k])
#define IN_X 0
#define IN_P 1
#define IN_POS 2
#define IN_PREMIX 3
#define IN_WIN 4
#define IN_RETG 5
#define IN_RETB 6
#define IN_KVG 7
#define IN_IKG 8
#define IN_IKB 9
#define IN_WUK 10
#define IN_WUV 11
#define IN_WOUT 12
#define IN_POSTMIX 13
#define IN_PREFFN 14
#define IN_WGATE 15
#define IN_WUP 16
#define IN_WDOWN 17
#define IN_POSTFFN 18
#define IN_WPU 19
#define IN_WPG 20
#define IN_PLEG 21

__device__ __forceinline__ float wave_sum(float v) {
#pragma unroll
    for (int o = 1; o < 64; o <<= 1) v += __shfl_xor(v, o);
    return v;
}
__device__ __forceinline__ float wave_max(float v) {
#pragma unroll
    for (int o = 1; o < 64; o <<= 1) v = fmaxf(v, __shfl_xor(v, o));
    return v;
}
__device__ __forceinline__ float wave_min(float v) {
#pragma unroll
    for (int o = 1; o < 64; o <<= 1) v = fminf(v, __shfl_xor(v, o));
    return v;
}
__device__ __forceinline__ int wave_sum_i(int v) {
#pragma unroll
    for (int o = 1; o < 64; o <<= 1) v += __shfl_xor(v, o);
    return v;
}

__device__ __forceinline__ int dest_row(int mode, int n) {
    if (mode == 0) return n;
    if (mode == 2) return 8 * (n >> 2) + (n & 3);
    if (mode == 3) return 8 * (n >> 2) + 4 + (n & 3);
    if (n < 1024) { const int d = n & 63, base = n & ~63; return d < 32 ? base + 8 * (d >> 2) + (d & 3) : base + 8 * ((d - 32) >> 2) + 4 + (d & 3); }
    if (n < 2560) return n;
    if (n < 2688) return 3072 + (n - 2560);
    if (n < 3200) return 2560 + (n - 2688);
    return n;
}
__device__ __forceinline__ void transpose_item(const float* W, int K, int N, bf16* WT, int mode, LAS float* scr, int item, int lane) {
    const int nblk = (N + 31) / 32, kb = item / nblk, nb = item % nblk, k0 = 64 * kb, n0 = 32 * nb;
    const int nn = n0 + (lane & 31);
#pragma unroll 8
    for (int i = 0; i < 32; ++i) { const int kk = 2 * i + (lane >> 5); scr[kk * 33 + (lane & 31)] = (nn < N) ? W[(size_t)(k0 + kk) * N + nn] : 0.f; }
    LDS_WAIT(); asm volatile("" ::: "memory");
    const int c = lane & 7;
#pragma unroll
    for (int j = 0; j < 4; ++j) { const int nl = (lane >> 3) + 8 * j; const LAS float* s = scr + (8 * c) * 33 + nl;
        v4u o; o.x = pk2(s[0 * 33], s[1 * 33]); o.y = pk2(s[2 * 33], s[3 * 33]); o.z = pk2(s[4 * 33], s[5 * 33]); o.w = pk2(s[6 * 33], s[7 * 33]);
        if (n0 + nl < N) *(GAS v4u*)(WT + (size_t)dest_row(mode, n0 + nl) * K + k0 + 8 * c) = o; }
    LDS_WAIT(); asm volatile("" ::: "memory");
}
__device__ __forceinline__ void norm_row(int lane, const float* tmp, const float* xin, float* xout, const float* g_post, const float* g_next, bf16* act, bool plain) {
    f32x4 x[4];
#pragma unroll
    for (int j = 0; j < 4; ++j) x[j] = ((const GAS f32x4*)xin)[lane + 64 * j];
    if (tmp) {
        f32x4 t[4]; float ss = 0.f;
#pragma unroll
        for (int j = 0; j < 4; ++j) { t[j] = ((const GAS f32x4*)tmp)[lane + 64 * j]; ss += (t[j].x * t[j].x + t[j].y * t[j].y) + (t[j].z * t[j].z + t[j].w * t[j].w); }
        const float r = 1.0f / sqrtf(wave_sum(ss) * (1.f / DM) + EPS);
#pragma unroll
        for (int j = 0; j < 4; ++j) { const f32x4 g = ((const GAS f32x4*)g_post)[lane + 64 * j]; x[j] = x[j] + t[j] * r * g; }
    }
    if (xout) {
#pragma unroll
        for (int j = 0; j < 4; ++j) ((GAS f32x4*)xout)[lane + 64 * j] = x[j];
    }
    if (act) {
        if (g_next) {
            float ss = 0.f;
#pragma unroll
            for (int j = 0; j < 4; ++j) ss += (x[j].x * x[j].x + x[j].y * x[j].y) + (x[j].z * x[j].z + x[j].w * x[j].w);
            const float r = 1.0f / sqrtf(wave_sum(ss) * (1.f / DM) + EPS);
#pragma unroll
            for (int j = 0; j < 4; ++j) { const f32x4 g = ((const GAS f32x4*)g_next)[lane + 64 * j]; x[j] = x[j] * r * g; }
        }
        (void)plain;
#pragma unroll
        for (int j = 0; j < 4; ++j) { v2u o; o.x = pk2(x[j].x, x[j].y); o.y = pk2(x[j].z, x[j].w); ((GAS v2u*)act)[lane + 64 * j] = o; }
    }
}

__device__ __forceinline__ void p0_prologue(Frame& F, const Args& A) {
    LAS float* scr = (LAS float*)(F.lds + RING_OFF + F.wave * 16384);
    const int gw = blockIdx.x * NWAVES + F.wave, NGW = F.G * NWAVES;
    const int gt = blockIdx.x * NTHREADS + F.tid, NGT = F.G * NTHREADS;
    unsigned char* ws = F.ws;
    for (int l = 0; l < DEPTH; ++l) {
        for (int mat = 0; mat < 7; ++mat) {
            const float* W; int K, N, mode; bf16* WT;
            switch (mat) {
                case 0: W = INP(IN_WIN) + (size_t)l * DM * NIN; K = DM; N = NIN; mode = 1; WT = (bf16*)(ws + WS_WIN) + (size_t)l * NINP * DM; break;
                case 1: W = INP(IN_WOUT) + (size_t)l * DM * DM; K = DM; N = DM; mode = 0; WT = (bf16*)(ws + WS_WOUT) + (size_t)l * DM * DM; break;
                case 2: W = INP(IN_WGATE) + (size_t)l * DM * DFF; K = DM; N = DFF; mode = 2; WT = (bf16*)(ws + WS_WGU) + (size_t)l * NGU * DM; break;
                case 3: W = INP(IN_WUP) + (size_t)l * DM * DFF; K = DM; N = DFF; mode = 3; WT = (bf16*)(ws + WS_WGU) + (size_t)l * NGU * DM; break;
                case 4: W = INP(IN_WDOWN) + (size_t)l * DFF * DM; K = DFF; N = DM; mode = 0; WT = (bf16*)(ws + WS_WD) + (size_t)l * DM * DFF; break;
                case 5: W = INP(IN_WPU) + (size_t)l * PLE * DM; K = PLE; N = DM; mode = 0; WT = (bf16*)(ws + WS_WPU) + (size_t)l * DM * PLE; break;
                default: W = INP(IN_WPG) + (size_t)l * DM * DM; K = DM; N = DM; mode = 0; WT = (bf16*)(ws + WS_WPG) + (size_t)l * DM * DM; break;
            }
            const int nitems = (K / 64) * ((N + 31) / 32);
            for (int it = gw; it < nitems; it += NGW) transpose_item(W, K, N, WT, mode, scr, it, F.lane);
        }
        { GAS v4u* z = (GAS v4u*)((bf16*)(ws + WS_WIN) + (size_t)l * NINP * DM + (size_t)NIN * DM); const int n16 = (NINP - NIN) * DM * 2 / 16;
          for (int i = gt; i < n16; i += NGT) z[i] = (v4u){0u, 0u, 0u, 0u}; }
    }
    { const GAS f32x4* src = (const GAS f32x4*)INP(IN_P); GAS v4u* dst = (GAS v4u*)(ws + WS_PB); const int n8 = DEPTH * M * PLE / 8;
      for (int i = gt; i < n8; i += NGT) { const f32x4 a = src[2 * i], b = src[2 * i + 1]; v4u o; o.x = pk2(a.x, a.y); o.y = pk2(a.z, a.w); o.z = pk2(b.x, b.y); o.w = pk2(b.z, b.w); dst[i] = o; } }
    { const int* pos = (const int*)INP(IN_POS); float* ct = (float*)(ws + WS_COS); float* st = (float*)(ws + WS_SIN);
      for (int i = gt; i < M * 32; i += NGT) { const int row = i >> 5, j = i & 31; const double inv = exp(-(double)j * (9.210340371976184 / 32.0)); const double ang = (double)pos[row] * inv;
          ct[i] = (float)cos(ang); st[i] = (float)sin(ang); } }
    for (int m = gw; m < M; m += NGW) norm_row(F.lane, nullptr, INP(IN_X) + (size_t)m * DM, nullptr, nullptr, INP(IN_PREMIX), (bf16*)(ws + WS_ACT) + (size_t)m * DM, false);
}

__device__ __forceinline__ void postproj_phase(Frame& F, const Args& A, int l) {
    const int gw = blockIdx.x * NWAVES + F.wave, NGW = F.G * NWAVES, lane = F.lane;
    const float* misc = (const float*)(F.ws + WS_MISC);
    bf16* ckv = (bf16*)(F.ws + WS_CKV); bf16* ki = (bf16*)(F.ws + WS_KI); float* wi = (float*)(F.ws + WS_WI);
    const float* kvg = INP(IN_KVG) + l * 128; const float* ikg = INP(IN_IKG) + l * 64; const float* ikb = INP(IN_IKB) + l * 64;
    for (int m = gw; m < M; m += NGW) {
        const f32x4 v = ((const GAS f32x4*)(misc + (size_t)m * 256))[lane];
        const float sq = (v.x * v.x + v.y * v.y) + (v.z * v.z + v.w * v.w), sm = (v.x + v.y) + (v.z + v.w);
        const bool isk = (lane >= 32 && lane < 48);
        const float ssc = wave_sum(lane < 32 ? sq : 0.f);
        const float mu = wave_sum(isk ? sm : 0.f) * (1.f / 64.f);
        const f32x4 dv = v - mu;
        const float var = wave_sum(isk ? ((dv.x * dv.x + dv.y * dv.y) + (dv.z * dv.z + dv.w * dv.w)) : 0.f) * (1.f / 64.f);
        if (lane < 32) { const float r = 1.0f / sqrtf(ssc * (1.f / 128.f) + EPS); const f32x4 g = *(const f32x4*)(kvg + 4 * lane); const f32x4 o = v * r * g;
            v2u w; w.x = pk2(o.x, o.y); w.y = pk2(o.z, o.w); ((GAS v2u*)(ckv + (size_t)m * 128))[lane] = w; }
        else if (isk) { const float r = 1.0f / sqrtf(var + EPS); const int d = 4 * (lane - 32); const f32x4 g = *(const f32x4*)(ikg + d), bb = *(const f32x4*)(ikb + d); const f32x4 o = dv * r * g + bb;
            v2u w; w.x = pk2(o.x, o.y); w.y = pk2(o.z, o.w); ((GAS v2u*)(ki + (size_t)m * 64))[lane - 32] = w; }
        else if (lane < 50) { ((GAS f32x4*)(wi + (size_t)m * 8))[lane - 48] = v * 0.04419417382415922f; }
    }
}

__device__ __forceinline__ void ret_naive_phase(Frame& F, const Args& A, int l) {
    LAS float* Ks = (LAS float*)(F.lds + RING_OFF); LAS float* Vs = Ks + 32 * 64;
    const bf16* RQ = (const bf16*)(F.ws + WS_PROJ); const bf16* RK = RQ + (size_t)M * 512; const bf16* RV = RK + (size_t)M * 512; const bf16* RG = RV + (size_t)M * 512;
    bf16* CAT = (bf16*)(F.ws + WS_CAT);
    const int tid = F.tid;
    for (int item = blockIdx.x; item < 256; item += F.G) {
        const int b = item >> 5, h = (item >> 2) & 7, tq = item & 3;
        const int t = 4 * tid + tq; const size_t row = (size_t)b * SEQ + t;
        float q[64], acc[64];
#pragma unroll
        for (int c = 0; c < 8; ++c) { const v4u w = *(const GAS v4u*)(RQ + row * 512 + h * 64 + c * 8);
            q[8 * c + 0] = bf_lo(w.x); q[8 * c + 1] = bf_hi(w.x); q[8 * c + 2] = bf_lo(w.y); q[8 * c + 3] = bf_hi(w.y); q[8 * c + 4] = bf_lo(w.z); q[8 * c + 5] = bf_hi(w.z); q[8 * c + 6] = bf_lo(w.w); q[8 * c + 7] = bf_hi(w.w); }
#pragma unroll
        for (int e = 0; e < 64; ++e) acc[e] = 0.f;
        const float lg2 = log2f(1.0f - exp2f(-5.0f - (float)h));
        for (int s0 = 0; s0 < SEQ; s0 += 32) {
            __syncthreads();
            { const int which = tid >> 8, r = (tid & 255) >> 3, c8 = tid & 7; const bf16* src = (which ? RV : RK) + ((size_t)b * SEQ + s0 + r) * 512 + h * 64 + c8 * 8;
              const v4u w = *(const GAS v4u*)src; LAS float* d = (which ? Vs : Ks) + r * 64 + c8 * 8;
              d[0] = bf_lo(w.x); d[1] = bf_hi(w.x); d[2] = bf_lo(w.y); d[3] = bf_hi(w.y); d[4] = bf_lo(w.z); d[5] = bf_hi(w.z); d[6] = bf_lo(w.w); d[7] = bf_hi(w.w); }
            __syncthreads();
            for (int s = 0; s < 32; ++s) { const int sg = s0 + s;
                if (sg <= t) { float dot = 0.f;
#pragma unroll
                    for (int d = 0; d < 64; ++d) dot += q[d] * Ks[s * 64 + d];
                    const float w = dot * exp2f(lg2 * (float)(t - sg));
#pragma unroll
                    for (int e = 0; e < 64; ++e) acc[e] += w * Vs[s * 64 + e]; } }
        }
        float mu = 0.f;
#pragma unroll
        for (int e = 0; e < 64; ++e) mu += acc[e];
        mu *= (1.f / 64.f); float var = 0.f;
#pragma unroll
        for (int e = 0; e < 64; ++e) { const float d = acc[e] - mu; var += d * d; }
        const float r = 1.0f / sqrtf(var * (1.f / 64.f) + EPS);
        const float* g = INP(IN_RETG) + (l * 8 + h) * 64; const float* bb = INP(IN_RETB) + (l * 8 + h) * 64;
#pragma unroll
        for (int c = 0; c < 8; ++c) { const v4u gw = *(const GAS v4u*)(RG + row * 512 + h * 64 + c * 8); float y[8];
#pragma unroll
            for (int i = 0; i < 8; ++i) y[i] = (acc[8 * c + i] - mu) * r * g[8 * c + i] + bb[8 * c + i];
            v4u o; o.x = pk2(bf_lo(gw.x) * y[0], bf_hi(gw.x) * y[1]); o.y = pk2(bf_lo(gw.y) * y[2], bf_hi(gw.y) * y[3]); o.z = pk2(bf_lo(gw.z) * y[4], bf_hi(gw.z) * y[5]); o.w = pk2(bf_lo(gw.w) * y[6], bf_hi(gw.w) * y[7]);
            *(GAS v4u*)(CAT + row * 1024 + h * 64 + c * 8) = o; }
    }
    __syncthreads();
}

__device__ __forceinline__ void dsa_naive_phase(Frame& F, const Args& A, int l) {
    LAS float* S = (LAS float*)(F.lds + RING_OFF) + F.wave * 4096;
    LAS float* qiS = S; LAS float* aqS = S + 512; LAS float* qlS = S + 1024; LAS unsigned* kuS = (LAS unsigned*)(S + 2048); LAS float* oS = S;
    const bf16* AQ = (const bf16*)(F.ws + WS_PROJ) + (size_t)4 * M * 512; const bf16* IQ = AQ + (size_t)M * 512;
    const bf16* CKV = (const bf16*)(F.ws + WS_CKV); const bf16* KI = (const bf16*)(F.ws + WS_KI); const float* WI = (const float*)(F.ws + WS_WI);
    const float* wuk = INP(IN_WUK) + (size_t)l * 8 * 64 * 128; const float* wuv = INP(IN_WUV) + (size_t)l * 8 * 128 * 64;
    bf16* CAT = (bf16*)(F.ws + WS_CAT);
    const int lane = F.lane;
    for (int gw = blockIdx.x * NWAVES + F.wave; gw < SEQ; gw += F.G * NWAVES)
    for (int k = 0; k < BATCH; ++k) {
        const int b = k, t = (k & 1) ? (SEQ - 1 - gw) : gw; const size_t row = (size_t)b * SEQ + t;
        { const v4u w = *(const GAS v4u*)(IQ + row * 512 + 8 * lane); LAS float* d = qiS + 8 * lane;
          d[0] = bf_lo(w.x); d[1] = bf_hi(w.x); d[2] = bf_lo(w.y); d[3] = bf_hi(w.y); d[4] = bf_lo(w.z); d[5] = bf_hi(w.z); d[6] = bf_lo(w.w); d[7] = bf_hi(w.w);
          const v4u a = *(const GAS v4u*)(AQ + row * 512 + 8 * lane); LAS float* e = aqS + 8 * lane;
          e[0] = bf_lo(a.x); e[1] = bf_hi(a.x); e[2] = bf_lo(a.y); e[3] = bf_hi(a.y); e[4] = bf_lo(a.z); e[5] = bf_hi(a.z); e[6] = bf_lo(a.w); e[7] = bf_hi(a.w); }
        const float wiv = WI[row * 8 + (lane & 7)];
        LDS_WAIT(); asm volatile("" ::: "memory");
        for (int h = 0; h < 8; ++h) { float a0 = 0.f, a1 = 0.f;
            for (int d = 0; d < 64; ++d) { const float a = aqS[h * 64 + d]; const float* wr_ = wuk + ((size_t)h * 64 + d) * 128; a0 += a * wr_[lane]; a1 += a * wr_[64 + lane]; }
            qlS[h * 128 + lane] = a0 * 0.125f; qlS[h * 128 + 64 + lane] = a1 * 0.125f; }
        for (int i = 0; i < 32; ++i) kuS[lane + 64 * i] = 0u;
        LDS_WAIT(); asm volatile("" ::: "memory");
        for (int i = 0; 64 * i <= t; ++i) { const int s = lane + 64 * i; const bf16* kr = KI + ((size_t)b * SEQ + s) * 64; float kf[64];
#pragma unroll
            for (int c = 0; c < 8; ++c) { const v4u w = *(const GAS v4u*)(kr + 8 * c);
                kf[8 * c + 0] = bf_lo(w.x); kf[8 * c + 1] = bf_hi(w.x); kf[8 * c + 2] = bf_lo(w.y); kf[8 * c + 3] = bf_hi(w.y); kf[8 * c + 4] = bf_lo(w.z); kf[8 * c + 5] = bf_hi(w.z); kf[8 * c + 6] = bf_lo(w.w); kf[8 * c + 7] = bf_hi(w.w); }
            float tot = 0.f;
            for (int h = 0; h < 8; ++h) { float dot = 0.f;
#pragma unroll
                for (int d = 0; d < 64; ++d) dot += qiS[h * 64 + d] * kf[d];
                tot += __shfl(wiv, h) * fmaxf(dot, 0.f); }
            const float v = tot + 0.0f; const unsigned u = __float_as_uint(v);
            if (s <= t) kuS[s] = (u & 0x80000000u) ? ~u : (u | 0x80000000u); }
        LDS_WAIT(); asm volatile("" ::: "memory");
        unsigned ku[32];
#pragma unroll
        for (int i = 0; i < 32; ++i) ku[i] = kuS[lane + 64 * i];
        const int kk = (t + 1 < 256) ? (t + 1) : 256;
        unsigned thr = 0u, tiekey = 0u; int need = 0;
        if (t + 1 > 256) {
            unsigned lo = 0u, hi = 0xFFFFFFFFu; bool exact = false;
            while (hi - lo > 1u) {
                const unsigned mid = lo + ((hi - lo) >> 1);
                int c = 0;
#pragma unroll
                for (int i = 0; i < 32; ++i) c += (ku[i] > mid) ? 1 : 0;
                c = wave_sum_i(c);
                if (c == kk) { thr = mid; exact = true; break; }
                if (c > kk) lo = mid; else hi = mid;
            }
            if (!exact) { int c = 0;
#pragma unroll
                for (int i = 0; i < 32; ++i) c += (ku[i] > hi) ? 1 : 0;
                c = wave_sum_i(c); thr = hi; tiekey = hi; need = kk - c; }
        }
        unsigned selm = 0u; int run = 0;
#pragma unroll
        for (int i = 0; i < 32; ++i) {
            bool sl = ku[i] > thr;
            if (need > 0) { const bool tie = (ku[i] == tiekey); const unsigned long long tb = __ballot(tie);
                const int rank = run + __popcll(tb & ((1ull << lane) - 1ull)); if (tie && rank < need) sl = true; run += __popcll(tb); }
            selm |= sl ? (1u << i) : 0u;
        }
        LAS float* pS = (LAS float*)kuS;
        for (int h = 0; h < 8; ++h) {
            float mx = -INFINITY;
            for (int i = 0; 64 * i <= t; ++i) { float dot = -INFINITY;
                if ((selm >> i) & 1u) { const int s = lane + 64 * i; const bf16* cr = CKV + ((size_t)b * SEQ + s) * 128; dot = 0.f;
#pragma unroll 4
                    for (int c4 = 0; c4 < 16; ++c4) { const v4u w = *(const GAS v4u*)(cr + 8 * c4); const LAS float* qq = qlS + h * 128 + 8 * c4;
                        dot += qq[0] * bf_lo(w.x) + qq[1] * bf_hi(w.x) + qq[2] * bf_lo(w.y) + qq[3] * bf_hi(w.y) + qq[4] * bf_lo(w.z) + qq[5] * bf_hi(w.z) + qq[6] * bf_lo(w.w) + qq[7] * bf_hi(w.w); }
                    mx = fmaxf(mx, dot); }
                pS[lane + 64 * i] = dot; }
            mx = wave_max(mx);
            float sum = 0.f;
            for (int i = 0; 64 * i <= t; ++i) { const float lgv = pS[lane + 64 * i]; const float p = ((selm >> i) & 1u) ? __expf(lgv - mx) : 0.f; pS[lane + 64 * i] = p; sum += p; }
            sum = wave_sum(sum);
            LDS_WAIT(); asm volatile("" ::: "memory");
            float o0 = 0.f, o1 = 0.f;
            for (int i = 0; 64 * i <= t; ++i) { unsigned long long mbits = __ballot((selm >> i) & 1u);
                while (mbits) { const int bit = __ffsll((long long)mbits) - 1; mbits &= mbits - 1ull; const float ps = pS[bit + 64 * i];
                    const unsigned w = ((const GAS unsigned*)(CKV + ((size_t)b * SEQ + bit + 64 * i) * 128))[lane]; o0 += ps * bf_lo(w); o1 += ps * bf_hi(w); } }
            LDS_WAIT(); asm volatile("" ::: "memory");
            const float inv = 1.0f / sum;
            oS[h * 128 + 2 * lane] = o0 * inv; oS[h * 128 + 2 * lane + 1] = o1 * inv;
        }
        LDS_WAIT(); asm volatile("" ::: "memory");
        for (int h = 0; h < 8; ++h) { float a = 0.f;
            for (int c = 0; c < 128; ++c) a += oS[h * 128 + c] * wuv[((size_t)h * 128 + c) * 64 + lane];
            CAT[row * 1024 + 512 + h * 64 + lane] = (bf16)f2bf(a); }
        LDS_WAIT(); asm volatile("" ::: "memory");
    }
}

__device__ __forceinline__ void norm_phase(Frame& F, const float* tmp, const float* xin, float* xout, const float* g_post, const float* g_next, bf16* act) {
    const int gw = blockIdx.x * NWAVES + F.wave, NGW = F.G * NWAVES;
    for (int m = gw; m < M; m += NGW) norm_row(F.lane, tmp + (size_t)m * DM, xin + (size_t)m * DM, xout + (size_t)m * DM, g_post, g_next, act ? act + (size_t)m * DM : nullptr, false);
}

#ifndef PH_MASK
#define PH_MASK 1023
#endif
template <int L> __device__ __forceinline__ void layer_phases(Frame& F, const Args& A, const XcdBarrier& bar, const int lo, const int hi) {
    constexpr int l = L, P0 = 1 + L * PH_PER_LAYER;
    unsigned char* ws = F.ws;
    bf16* ACT = (bf16*)(ws + WS_ACT);
    const float* xin = (l == 0) ? INP(IN_X) : F.out;
#define IN(k) (lo <= (k) && (k) < hi)
#define SEAM(k) do { if (IN(k) && IN((k) + 1)) xcd_barrier(bar); } while (0)
    if (IN(P0 + 0)) {
#if (PH_MASK >> 0) & 1
        pg8::Gemm g{ACT, (const bf16*)(ws + WS_WIN) + (size_t)l * NINP * DM, M, NINP, DM}; pg8::StaticOrder S; S.init(M, NINP, F.G, (int)blockIdx.x);
        pg8::EpiInProj E{(bf16*)(ws + WS_PROJ), (float*)(ws + WS_MISC), (const float*)(ws + WS_COS), (const float*)(ws + WS_SIN), M};
        pg8::gemm_phase<pg8::EpiInProj, pg8::StaticOrder, true, true>(F.lds + RING_OFF, g, S, E);
#endif
    }
    SEAM(P0 + 0);
    if (IN(P0 + 1)) {
#if (PH_MASK >> 1) & 1
        postproj_phase(F, A, l);
#endif
    }
    SEAM(P0 + 1);
    if (IN(P0 + 2)) {
#if (PH_MASK >> 2) & 1
#ifndef NO_RET
        ret_naive_phase(F, A, l);
#endif
#ifndef NO_DSA
        dsa_naive_phase(F, A, l);
#endif
#endif
    }
    SEAM(P0 + 2);
    if (IN(P0 + 3)) {
#if (PH_MASK >> 3) & 1
        pg8::Gemm g{(const bf16*)(ws + WS_CAT), (const bf16*)(ws + WS_WOUT) + (size_t)l * DM * DM, M, DM, DM}; pg8::StaticOrder S; S.init(M, DM, F.G, (int)blockIdx.x);
        pg8::EpiF32 E{(float*)(ws + WS_TMPD), DM};
        pg8::gemm_phase<pg8::EpiF32, pg8::StaticOrder, true, true>(F.lds + RING_OFF, g, S, E);
#endif
    }
    SEAM(P0 + 3);
    if (IN(P0 + 4)) {
#if (PH_MASK >> 4) & 1
        norm_phase(F, (const float*)(ws + WS_TMPD), xin, F.out, INP(IN_POSTMIX) + l * DM, INP(IN_PREFFN) + l * DM, ACT);
#endif
    }
    SEAM(P0 + 4);
    if (IN(P0 + 5)) {
#if (PH_MASK >> 5) & 1
        pg8::Gemm g{ACT, (const bf16*)(ws + WS_WGU) + (size_t)l * NGU * DM, M, NGU, DM}; pg8::StaticOrder S; S.init(M, NGU, F.G, (int)blockIdx.x);
        pg8::EpiSwiGLU E{(bf16*)(ws + WS_HFF), DFF};
        pg8::gemm_phase<pg8::EpiSwiGLU, pg8::StaticOrder, true, true>(F.lds + RING_OFF, g, S, E);
#endif
    }
    SEAM(P0 + 5);
    if (IN(P0 + 6)) {
#if (PH_MASK >> 6) & 1
        pg8::Gemm g{(const bf16*)(ws + WS_HFF), (const bf16*)(ws + WS_WD) + (size_t)l * DM * DFF, M, DM, DFF}; pg8::StaticOrder S; S.init(M, DM, F.G, (int)blockIdx.x);
        pg8::EpiF32 E{(float*)(ws + WS_TMPF), DM};
        pg8::gemm_phase<pg8::EpiF32, pg8::StaticOrder, true, true>(F.lds + RING_OFF, g, S, E);
#endif
    }
    SEAM(P0 + 6);
    if (IN(P0 + 7)) {
#if (PH_MASK >> 7) & 1
        norm_phase(F, (const float*)(ws + WS_TMPF), F.out, F.out, INP(IN_POSTFFN) + l * DM, nullptr, (bf16*)(ws + WS_XB));
#endif
    }
    SEAM(P0 + 7);
    if (IN(P0 + 8)) {
#if (PH_MASK >> 8) & 1
        { int Kp = PLE; asm volatile("" : "+s"(Kp));
          pg8::Gemm g{(const bf16*)(ws + WS_PB) + (size_t)l * M * PLE, (const bf16*)(ws + WS_WPU) + (size_t)l * DM * PLE, M, DM, Kp}; pg8::StaticOrder S; S.init(M, DM, F.G, (int)blockIdx.x);
          pg8::EpiBf16Plain E{(bf16*)(ws + WS_EB), DM};
          pg8::gemm_phase<pg8::EpiBf16Plain, pg8::StaticOrder, true, true>(F.lds + RING_OFF, g, S, E); }
        VM_WAIT(); __threadfence(); __syncthreads();
        { pg8::Gemm g{(const bf16*)(ws + WS_XB), (const bf16*)(ws + WS_WPG) + (size_t)l * DM * DM, M, DM, DM}; pg8::StaticOrder S; S.init(M, DM, F.G, (int)blockIdx.x);
          pg8::EpiGateMul E{(const bf16*)(ws + WS_EB), (float*)(ws + WS_TMPG), DM};
          pg8::gemm_phase<pg8::EpiGateMul, pg8::StaticOrder, true, true>(F.lds + RING_OFF, g, S, E); }
#endif
    }
    SEAM(P0 + 8);
    if (IN(P0 + 9)) {
#if (PH_MASK >> 9) & 1
        norm_phase(F, (const float*)(ws + WS_TMPG), F.out, F.out, INP(IN_PLEG) + l * DM, (l + 1 < DEPTH) ? INP(IN_PREMIX) + (l + 1) * DM : nullptr, (l + 1 < DEPTH) ? ACT : nullptr);
#endif
    }
    SEAM(P0 + 9);
#undef IN
#undef SEAM
}

__global__ void __launch_bounds__(NWAVES * 64, 2) fwd_mega(Args A) {
    extern __shared__ __attribute__((aligned(16))) unsigned char lds[];
    Frame F;
    F.lds = (LAS unsigned char*)lds;
    F.MISC = (volatile LAS unsigned*)(F.lds + MISC_OFF);
    F.tid = threadIdx.x; F.lane = F.tid & 63; F.wave = __builtin_amdgcn_readfirstlane(F.tid >> 6);
    F.G = gridDim.x;
    F.ws = A.ws; F.out = A.out; F.ctl = (gu32*)(A.ws + WS_CTL);
    for (int u = F.tid; u < (LDS_BYTES - LDSCTL_OFF) / 4; u += NWAVES * 64) ((LAS unsigned*)(F.lds + LDSCTL_OFF))[u] = 0u;
    __syncthreads();
    const int lo = A.ph_lo, hi = A.ph_hi;
    XcdBarrier bar; bar.bar = (unsigned*)(F.ctl + CW_BAR); bar.x = 0; bar.st = nullptr;
    if (hi - lo > 1) bar = xcd_barrier_post((unsigned*)(F.ctl + CW_BAR), F.MISC + 8);
#define IN(k) (lo <= (k) && (k) < hi)
#define SEAM(k) do { if (IN(k) && IN((k) + 1)) xcd_barrier(bar); } while (0)
    if (IN(0)) p0_prologue(F, A);
    SEAM(0);
    layer_phases<0>(F, A, bar, lo, hi);
    layer_phases<1>(F, A, bar, lo, hi);
}

extern "C" void kernel_launch(void* const* d_in, const int* in_sizes, int n_in, void* d_out, int out_size, void* d_ws, size_t ws_size, hipStream_t stream) {
    static int grid = 0;
    if (grid == 0) {
        if (n_in != 22 || out_size != M * DM || ws_size < WS_END) { fprintf(stderr, "kernel_launch: unexpected shapes: n_in %d out %d ws %zu\n", n_in, out_size, ws_size); grid = -1; return; }
        int dev = 0, cus = 0;
        if (hipGetDevice(&dev) != hipSuccess || hipDeviceGetAttribute(&cus, hipDeviceAttributeMultiprocessorCount, dev) != hipSuccess) { grid = -1; return; }
        if (hipFuncSetAttribute((const void*)fwd_mega, hipFuncAttributeMaxDynamicSharedMemorySize, LDS_BYTES) != hipSuccess) { fprintf(stderr, "kernel_launch: hipFuncSetAttribute failed\n"); grid = -1; return; }
        (void)hipGetLastError();
        grid = cus;
    }
    if (grid < 0) return;
    if (hipMemsetAsync((char*)d_ws + WS_CTL, 0, CTL_ZERO_BYTES, stream) != hipSuccess) return;
    Args a{};
    for (int i = 0; i < 22; ++i) a.in[i] = d_in[i];
    a.out = (float*)d_out; a.ws = (unsigned char*)d_ws;
#if MK_PER_PHASE
    for (int ph = 0; ph < NPH; ++ph) { a.ph_lo = ph; a.ph_hi = ph + 1; hipLaunchKernelGGL(fwd_mega, dim3(grid), dim3(NWAVES * 64), LDS_BYTES, stream, a); }
#else
    a.ph_lo = 0; a.ph_hi = NPH;
    hipLaunchKernelGGL(fwd_mega, dim3(grid), dim3(NWAVES * 64), LDS_BYTES, stream, a);
#endif
}
```

```cpp
#include <hip/hip_runtime.h>
#include <cstdio>
#include <cstdint>
#include <cmath>

#ifndef MK_PER_PHASE
#define MK_PER_PHASE 0
#endif

namespace pg8 {
#define PG8_LAS __attribute__((address_space(3)))
typedef unsigned short bf16_t;
typedef short bf16x8 __attribute__((ext_vector_type(8)));
typedef float f32x4 __attribute__((ext_vector_type(4)));
typedef unsigned u32x4 __attribute__((ext_vector_type(4)));
typedef unsigned u32x2 __attribute__((ext_vector_type(2)));
constexpr int BM = 256, BK = 64, HALF = 128, HTB = HALF * BK * 2, STAGE_BYTES = 8 * HTB, NXCD = 8, WGM = 8;

__host__ __device__ __forceinline__ int lds_byte(int r, int c) { const int st = (r >> 4) * 2 + (c >> 5), rr = r & 15, cc = c & 31, ob = rr * 64 + cc * 2; return st * 1024 + (ob ^ (((ob >> 9) & 1) << 5)); }
__host__ __device__ __forceinline__ void stage_rc(int b, int& R, int& C) { const int st = b / 1024, sb = b % 1024, swz = sb ^ (((sb >> 9) & 1) << 5); R = (st >> 1) * 16 + swz / 64; C = (st & 1) * 32 + (swz % 64) / 2; }
__host__ __device__ __forceinline__ int perm32(int rho) { const int n = rho >> 4, i = rho & 15; return 8 * (i >> 2) + 4 * n + (i & 3); }

struct Unit { int pm, pn; };
struct Gemm { const bf16_t* A; const bf16_t* Bt; int M, N, K; };

struct StaticOrder {
    int nM, nN, nwg, G, c;
    __host__ __device__ void init(int M, int N, int G_, int c_) { nM = M / BM; nN = N / BM; nwg = nM * nN; G = G_; c = c_; }
    __host__ __device__ bool next(int i, Unit& u) const {
        const long L = (long)i * G + c; if (L >= nwg) return false;
        int wgid = (int)L; { const int q = nwg / NXCD, r = nwg % NXCD, xcd = wgid % NXCD, off = wgid / NXCD; wgid = (xcd < r ? xcd * (q + 1) : r * (q + 1) + (xcd - r) * q) + off; }
        const int nig = WGM * nN, gid = wgid / nig, fm = gid * WGM, gsz = (nM - fm) < WGM ? (nM - fm) : WGM;
        u.pm = fm + ((wgid % nig) % gsz); u.pn = (wgid % nig) / gsz; return true;
    }
    __device__ __forceinline__ void a_ready(const Unit&) const {}
    __device__ __forceinline__ void done(const Unit&) const {}
};

__device__ __forceinline__ unsigned cvt_pk_bf16(float lo, float hi) { unsigned r; asm volatile("v_cvt_pk_bf16_f32 %0, %1, %2" : "=v"(r) : "v"(lo), "v"(hi)); return r; }
__device__ __forceinline__ float silu_f(float x) { return x / (1.f + __expf(-x)); }
__device__ __forceinline__ float sigmoid_f(float x) { return 1.f / (1.f + __expf(-x)); }
__device__ __forceinline__ float bf_lo(unsigned w) { return __uint_as_float(w << 16); }
__device__ __forceinline__ float bf_hi(unsigned w) { return __uint_as_float(w & 0xffff0000u); }


struct EpiInProj {
    static constexpr bool PERM = true, AFTER_DRAIN = false;
    bf16_t* proj; float* misc; const float* cosT; const float* sinT; int Mrows;
    __device__ __forceinline__ void operator()(const f32x4 (&acc)[2][2][4][2], const Unit& u, int wr, int wc, int fr, int fq) const {
        const int row0 = u.pm * BM + wr * 64 + fr;
        if (u.pn == 12) {
#pragma unroll
            for (int ai = 0; ai < 2; ++ai)
#pragma unroll
                for (int m = 0; m < 4; ++m) { float* rowp = misc + (size_t)(row0 + ai * HALF + m * 16) * 256 + wc * 32 + 8 * fq;
#pragma unroll
                    for (int bj = 0; bj < 2; ++bj) { *(f32x4*)(rowp + bj * HALF) = acc[ai][bj][m][0]; *(f32x4*)(rowp + bj * HALF + 4) = acc[ai][bj][m][1]; } }
            return;
        }
        const int t = u.pn >> 1, colt = (u.pn & 1) * 256 + wc * 32 + 8 * fq;
        bf16_t* base = proj + (size_t)t * Mrows * 512;
        const int u8 = ((wc & 1) * 4 + fq);
#pragma unroll
        for (int ai = 0; ai < 2; ++ai)
#pragma unroll
            for (int m = 0; m < 4; ++m) { const int row = row0 + ai * HALF + m * 16; bf16_t* rowp = base + (size_t)row * 512 + colt;
                f32x4 cs = {1.f, 1.f, 1.f, 1.f}, sn = {0.f, 0.f, 0.f, 0.f};
                if (t <= 1) { cs = *(const f32x4*)(cosT + (size_t)row * 32 + 4 * u8); sn = *(const f32x4*)(sinT + (size_t)row * 32 + 4 * u8); }
#pragma unroll
                for (int bj = 0; bj < 2; ++bj) { f32x4 v0 = acc[ai][bj][m][0], v1 = acc[ai][bj][m][1];
                    if (t <= 1) { const f32x4 o0 = v0 * cs - v1 * sn, o1 = v0 * sn + v1 * cs; v0 = o0; v1 = o1; if (t == 1) { v0 = v0 * 0.125f; v1 = v1 * 0.125f; } }
                    else if (t == 3) {
#pragma unroll
                        for (int i = 0; i < 4; ++i) { v0[i] = silu_f(v0[i]); v1[i] = silu_f(v1[i]); } }
                    u32x4 w; w.x = cvt_pk_bf16(v0[0], v0[1]); w.y = cvt_pk_bf16(v0[2], v0[3]); w.z = cvt_pk_bf16(v1[0], v1[1]); w.w = cvt_pk_bf16(v1[2], v1[3]);
                    *(u32x4*)(rowp + bj * HALF) = w; } }
    }
};
struct EpiF32 {
    static constexpr bool PERM = false, AFTER_DRAIN = false;
    float* C; int ldc;
    __device__ __forceinline__ void operator()(const f32x4 (&acc)[2][2][4][2], const Unit& u, int wr, int wc, int fr, int fq) const {
        const int row0 = u.pm * BM + wr * 64 + fr, col0 = u.pn * BM + wc * 32 + 4 * fq;
#pragma unroll
        for (int ai = 0; ai < 2; ++ai)
#pragma unroll
            for (int m = 0; m < 4; ++m) { float* rowp = C + (size_t)(row0 + ai * HALF + m * 16) * ldc + col0;
#pragma unroll
                for (int bj = 0; bj < 2; ++bj)
#pragma unroll
                    for (int n = 0; n < 2; ++n) *(f32x4*)(rowp + bj * HALF + n * 16) = acc[ai][bj][m][n]; }
    }
};
struct EpiSwiGLU {
    static constexpr bool PERM = true, AFTER_DRAIN = false;
    bf16_t* O; int ldo;
    __device__ __forceinline__ void operator()(const f32x4 (&acc)[2][2][4][2], const Unit& u, int wr, int wc, int fr, int fq) const {
        const int row0 = u.pm * BM + wr * 64 + fr, hcol0 = u.pn * 128 + wc * 16 + 4 * fq;
#pragma unroll
        for (int ai = 0; ai < 2; ++ai)
#pragma unroll
            for (int m = 0; m < 4; ++m) { bf16_t* rowp = O + (size_t)(row0 + ai * HALF + m * 16) * ldo + hcol0;
#pragma unroll
                for (int bj = 0; bj < 2; ++bj) { const f32x4 g = acc[ai][bj][m][0], up = acc[ai][bj][m][1]; f32x4 o;
#pragma unroll
                    for (int i = 0; i < 4; ++i) o[i] = silu_f(g[i]) * up[i];
                    u32x2 w; w.x = cvt_pk_bf16(o[0], o[1]); w.y = cvt_pk_bf16(o[2], o[3]);
                    *(u32x2*)(rowp + bj * 64) = w; } }
    }
};
struct EpiBf16Plain {
    static constexpr bool PERM = true, AFTER_DRAIN = false;
    bf16_t* O; int ldo;
    __device__ __forceinline__ void operator()(const f32x4 (&acc)[2][2][4][2], const Unit& u, int wr, int wc, int fr, int fq) const {
        const int row0 = u.pm * BM + wr * 64 + fr, col0 = u.pn * BM + wc * 32 + 8 * fq;
#pragma unroll
        for (int ai = 0; ai < 2; ++ai)
#pragma unroll
            for (int m = 0; m < 4; ++m) { bf16_t* rowp = O + (size_t)(row0 + ai * HALF + m * 16) * ldo + col0;
#pragma unroll
                for (int bj = 0; bj < 2; ++bj) { const f32x4 v0 = acc[ai][bj][m][0], v1 = acc[ai][bj][m][1];
                    u32x4 w; w.x = cvt_pk_bf16(v0[0], v0[1]); w.y = cvt_pk_bf16(v0[2], v0[3]); w.z = cvt_pk_bf16(v1[0], v1[1]); w.w = cvt_pk_bf16(v1[2], v1[3]);
                    *(u32x4*)(rowp + bj * HALF) = w; } }
    }
};
struct EpiGateMul {
    static constexpr bool PERM = true, AFTER_DRAIN = false;
    const bf16_t* E; float* C; int ldc;
    __device__ __forceinline__ void operator()(const f32x4 (&acc)[2][2][4][2], const Unit& u, int wr, int wc, int fr, int fq) const {
        const int row0 = u.pm * BM + wr * 64 + fr, col0 = u.pn * BM + wc * 32 + 8 * fq;
#pragma unroll
        for (int ai = 0; ai < 2; ++ai)
#pragma unroll
            for (int m = 0; m < 4; ++m) { const size_t off = (size_t)(row0 + ai * HALF + m * 16) * ldc + col0;
#pragma unroll
                for (int bj = 0; bj < 2; ++bj) { const u32x4 e = *(const u32x4*)(E + off + bj * HALF); const f32x4 v0 = acc[ai][bj][m][0], v1 = acc[ai][bj][m][1]; f32x4 o0, o1;
                    o0[0] = sigmoid_f(v0[0]) * bf_lo(e.x); o0[1] = sigmoid_f(v0[1]) * bf_hi(e.x); o0[2] = sigmoid_f(v0[2]) * bf_lo(e.y); o0[3] = sigmoid_f(v0[3]) * bf_hi(e.y);
                    o1[0] = sigmoid_f(v1[0]) * bf_lo(e.z); o1[1] = sigmoid_f(v1[1]) * bf_hi(e.z); o1[2] = sigmoid_f(v1[2]) * bf_lo(e.w); o1[3] = sigmoid_f(v1[3]) * bf_hi(e.w);
                    *(f32x4*)(C + off + bj * HALF) = o0; *(f32x4*)(C + off + bj * HALF + 4) = o1; }
                asm volatile("" ::: "memory"); }
    }
};

template <class Epi, class Sched, bool ALIGN_EPI = false, bool SP2 = false>
__device__ __forceinline__ void gemm_phase(PG8_LAS unsigned char* lds, const Gemm g, const Sched& S, const Epi& E) {
    const int tid = threadIdx.x, wid = __builtin_amdgcn_readfirstlane(tid >> 6), lane = tid & 63, wr = wid >> 2, wc = wid & 3, fr = lane & 15, fq = lane >> 4;
    const int K = g.K, nt = K / BK;
    unsigned voffA[2], voffB[2];
#pragma unroll
    for (int i = 0; i < 2; ++i) { int R, C; stage_rc(tid * 16 + i * 8192, R, C); const int Rb = Epi::PERM ? ((R & ~31) + perm32(R & 31)) : R;
        voffA[i] = (unsigned)(R * K + C) * 2u; voffB[i] = (unsigned)(Rb * K + C) * 2u; }
    const size_t kstep = (size_t)(BK * 2);
    const size_t hstep = (size_t)HALF * K * 2;
    const size_t tstep = 2 * hstep;
    const unsigned ldsw = (unsigned)wid * 1024u;
    const int aoff = lds_byte(wr * 64 + fr, fq * 8), boff = lds_byte(wc * 32 + fr, fq * 8);
#define PG8_SA(b, h) (((b) * 2 + (h)) * HTB)
#define PG8_SB(b, h) ((4 + (b) * 2 + (h)) * HTB)
#define PG8_STAGE(bufoff, gbase, voff) do { _Pragma("unroll") for (int _i = 0; _i < 2; ++_i) \
        __builtin_amdgcn_global_load_lds((const unsigned*)((const char*)(gbase) + (voff)[_i]), (PG8_LAS unsigned*)(lds + (bufoff) + ldsw + _i * 8192), 16, 0, 0); } while (0)
#define PG8_LDA(dst, b, h) do { _Pragma("unroll") for (int m = 0; m < 4; ++m) _Pragma("unroll") for (int k = 0; k < 2; ++k) dst[m][k] = *(const PG8_LAS bf16x8*)(lds + PG8_SA(b, h) + aoff + m * 2048 + k * 1024); } while (0)
#define PG8_LDB(dst, b, h) do { _Pragma("unroll") for (int n = 0; n < 2; ++n) _Pragma("unroll") for (int k = 0; k < 2; ++k) dst[n][k] = *(const PG8_LAS bf16x8*)(lds + PG8_SB(b, h) + boff + n * 2048 + k * 1024); } while (0)
#define PG8_MMA(ai, bj, At, Bt) do { __builtin_amdgcn_s_setprio(1); _Pragma("unroll") for (int m = 0; m < 4; ++m) _Pragma("unroll") for (int n = 0; n < 2; ++n) _Pragma("unroll") for (int k = 0; k < 2; ++k) \
        acc[ai][bj][m][n] = __builtin_amdgcn_mfma_f32_16x16x32_bf16(Bt[n][k], At[m][k], acc[ai][bj][m][n], 0, 0, 0); __builtin_amdgcn_s_setprio(0); } while (0)
#define PG8_WAIT_V(n) asm volatile("s_waitcnt vmcnt(" #n ")" ::: "memory")
#define PG8_WAIT_L(n) asm volatile("s_waitcnt lgkmcnt(" #n ")" ::: "memory")
#define PG8_BAR __builtin_amdgcn_s_barrier()
#define PG8_SCHED __builtin_amdgcn_sched_barrier(0)
    Unit cur, nxt; int ui = 0;
    if (!S.next(0, cur)) return;
    f32x4 acc[2][2][4][2];
#pragma unroll
    for (int a = 0; a < 2; ++a)
#pragma unroll
        for (int b = 0; b < 2; ++b)
#pragma unroll
            for (int m = 0; m < 4; ++m)
#pragma unroll
                for (int n = 0; n < 2; ++n) acc[a][b][m][n] = (f32x4){0.f, 0.f, 0.f, 0.f};
    bf16x8 At[4][2], B0[2][2], B1[2][2];
    const char* cA = (const char*)g.A + (size_t)cur.pm * tstep; const char* cB = (const char*)g.Bt + (size_t)cur.pn * tstep;
    S.a_ready(cur);
    if constexpr (SP2) {
        PG8_STAGE(PG8_SB(0, 0), cB, voffB); PG8_STAGE(PG8_SB(0, 1), cB + hstep, voffB); PG8_STAGE(PG8_SA(0, 0), cA, voffA); PG8_STAGE(PG8_SA(0, 1), cA + hstep, voffA);
        if (wr == 1) PG8_BAR;
        PG8_WAIT_V(2); PG8_BAR;
        PG8_STAGE(PG8_SB(1, 0), cB + kstep, voffB); PG8_STAGE(PG8_SA(1, 0), cA + kstep, voffA); PG8_STAGE(PG8_SB(1, 1), cB + hstep + kstep, voffB);
        PG8_WAIT_V(6); PG8_BAR;
    } else {
        PG8_STAGE(PG8_SB(0, 0), cB, voffB); PG8_STAGE(PG8_SA(0, 0), cA, voffA); PG8_STAGE(PG8_SB(0, 1), cB + hstep, voffB); PG8_STAGE(PG8_SA(0, 1), cA + hstep, voffA);
        if (wr == 1) PG8_BAR;
        PG8_WAIT_V(4); PG8_BAR;
        PG8_STAGE(PG8_SB(1, 0), cB + kstep, voffB); PG8_STAGE(PG8_SA(1, 0), cA + kstep, voffA); PG8_STAGE(PG8_SB(1, 1), cB + hstep + kstep, voffB);
        PG8_WAIT_V(6); PG8_BAR;
    }
    for (;;) {
        const bool has_next = S.next(ui + 1, nxt);
        const char* nA = has_next ? (const char*)g.A + (size_t)nxt.pm * tstep : cA; const char* nB = has_next ? (const char*)g.Bt + (size_t)nxt.pn * tstep : cB;
        for (int t = 0; t < nt; t += 2) {
            const bool last = (t == nt - 2);
            const char* a1 = cA + (size_t)(t + 1) * kstep;
            const char* a2 = last ? nA : cA + (size_t)(t + 2) * kstep; const char* b2 = last ? nB : cB + (size_t)(t + 2) * kstep;
            const char* a3 = a2 + kstep; const char* b3 = b2 + kstep;
            if (last && has_next) S.a_ready(nxt);
            if constexpr (SP2) {
            PG8_LDB(B0, 0, 0); PG8_LDB(B1, 0, 1); PG8_SCHED; PG8_LDA(At, 0, 0); PG8_STAGE(PG8_SA(1, 1), a1 + hstep, voffA);
            PG8_WAIT_V(8); PG8_WAIT_L(0); PG8_BAR; PG8_MMA(0, 0, At, B0); PG8_MMA(0, 1, At, B1); PG8_BAR; PG8_SCHED;
            PG8_LDA(At, 0, 1); PG8_STAGE(PG8_SB(0, 0), b2, voffB); PG8_STAGE(PG8_SB(0, 1), b2 + hstep, voffB); PG8_STAGE(PG8_SA(0, 0), a2, voffA);
            PG8_WAIT_V(8); PG8_WAIT_L(0); PG8_BAR; PG8_MMA(1, 0, At, B0); PG8_MMA(1, 1, At, B1); PG8_BAR; PG8_SCHED;
            PG8_LDB(B0, 1, 0); PG8_LDB(B1, 1, 1); PG8_SCHED; PG8_LDA(At, 1, 0); PG8_STAGE(PG8_SA(0, 1), a2 + hstep, voffA);
            PG8_WAIT_V(8); PG8_WAIT_L(0); PG8_BAR; PG8_MMA(0, 0, At, B0); PG8_MMA(0, 1, At, B1); PG8_BAR; PG8_SCHED;
            PG8_LDA(At, 1, 1); PG8_STAGE(PG8_SB(1, 0), b3, voffB); PG8_STAGE(PG8_SB(1, 1), b3 + hstep, voffB); PG8_STAGE(PG8_SA(1, 0), a3, voffA);
            PG8_WAIT_V(8); PG8_WAIT_L(0); PG8_BAR; PG8_MMA(1, 0, At, B0); PG8_MMA(1, 1, At, B1); PG8_BAR; PG8_SCHED;
            } else {
            PG8_LDB(B0, 0, 0); PG8_SCHED; PG8_LDA(At, 0, 0); PG8_STAGE(PG8_SA(1, 1), a1 + hstep, voffA);
            PG8_WAIT_L(8); PG8_BAR; PG8_WAIT_L(0); PG8_MMA(0, 0, At, B0); PG8_BAR; PG8_SCHED;
            PG8_LDB(B1, 0, 1); PG8_STAGE(PG8_SB(0, 0), b2, voffB);
            PG8_BAR; PG8_WAIT_L(0); PG8_MMA(0, 1, At, B1); PG8_BAR;
            PG8_LDA(At, 0, 1); PG8_STAGE(PG8_SA(0, 0), a2, voffA);
            PG8_BAR; PG8_WAIT_L(0); PG8_MMA(1, 0, At, B0); PG8_BAR; PG8_SCHED;
            PG8_STAGE(PG8_SB(0, 1), b2 + hstep, voffB);
            PG8_WAIT_V(6); PG8_BAR; PG8_MMA(1, 1, At, B1); PG8_BAR;
            PG8_LDB(B0, 1, 0); PG8_SCHED; PG8_LDA(At, 1, 0); PG8_STAGE(PG8_SA(0, 1), a2 + hstep, voffA);
            PG8_WAIT_L(8); PG8_BAR; PG8_WAIT_L(0); PG8_MMA(0, 0, At, B0); PG8_BAR; PG8_SCHED;
            PG8_LDB(B1, 1, 1); PG8_STAGE(PG8_SB(1, 0), b3, voffB);
            PG8_BAR; PG8_WAIT_L(0); PG8_MMA(0, 1, At, B1); PG8_BAR;
            PG8_LDA(At, 1, 1); PG8_STAGE(PG8_SA(1, 0), a3, voffA);
            PG8_BAR; PG8_WAIT_L(0); PG8_MMA(1, 0, At, B0); PG8_BAR; PG8_SCHED;
            PG8_STAGE(PG8_SB(1, 1), b3 + hstep, voffB);
            PG8_WAIT_V(6); PG8_BAR; PG8_MMA(1, 1, At, B1); PG8_BAR;
            }
        }
        if constexpr (ALIGN_EPI) { if (wr == 0) PG8_BAR; }
        if constexpr (!Epi::AFTER_DRAIN) { E(acc, cur, wr, wc, fr, fq); S.done(cur); }
        if (!has_next) break;
#pragma unroll
        for (int a = 0; a < 2; ++a)
#pragma unroll
            for (int b = 0; b < 2; ++b)
#pragma unroll
                for (int m = 0; m < 4; ++m)
#pragma unroll
                    for (int n = 0; n < 2; ++n) acc[a][b][m][n] = (f32x4){0.f, 0.f, 0.f, 0.f};
        cur = nxt; cA = nA; cB = nB; ++ui;
        if constexpr (ALIGN_EPI) { if (wr == 1) PG8_BAR; }
    }
    PG8_WAIT_V(0);
    if constexpr (!ALIGN_EPI) { if (wr == 0) PG8_BAR; }
    PG8_BAR;
    if constexpr (Epi::AFTER_DRAIN) { E.fused(acc, cur, wr, wc, fr, fq, lds, wid, lane); S.done(cur); }
#undef PG8_SA
#undef PG8_SB
#undef PG8_STAGE
#undef PG8_LDA
#undef PG8_LDB
#undef PG8_MMA
#undef PG8_WAIT_V
#undef PG8_WAIT_L
#undef PG8_BAR
#undef PG8_SCHED
}
}

constexpr int NWAVES = 8, NTHREADS = 512;
constexpr int BATCH = 8, SEQ = 2048, DM = 1024, M = BATCH * SEQ, DEPTH = 2;
constexpr int NIN = 3272, NINP = 3328, DFF = 2816, PLE = 256, NGU = 2 * DFF;
constexpr float EPS = 1e-6f;
constexpr int PH_PER_LAYER = 10, NPH = 1 + DEPTH * PH_PER_LAYER;

constexpr size_t MiB = 1u << 20;
constexpr size_t WS_CTL = 0, CTL_ZERO_BYTES = 1 * MiB;
constexpr size_t WS_WIN = 1 * MiB, WS_WOUT = 14 * MiB, WS_WGU = 18 * MiB, WS_WD = 40 * MiB, WS_WPU = 51 * MiB, WS_WPG = 52 * MiB, WS_WUK = 56 * MiB, WS_WUV = 56 * MiB + 512 * 1024;
constexpr size_t WS_PB = 57 * MiB, WS_COS = 73 * MiB, WS_SIN = 75 * MiB;
constexpr size_t WS_PROJ = 80 * MiB;
constexpr size_t WS_HFF = 80 * MiB, WS_TMPD = 80 * MiB, WS_XB = 80 * MiB, WS_TMPG = 112 * MiB;
constexpr size_t WS_ACT = 176 * MiB;
constexpr size_t WS_CKV = 176 * MiB, WS_KI = 180 * MiB, WS_WI = 182 * MiB, WS_RST = 184 * MiB, WS_KV = 192 * MiB;
constexpr size_t WS_CAT = 208 * MiB, WS_EB = 208 * MiB;
constexpr size_t WS_TMPF = 176 * MiB;
constexpr size_t WS_MISC = 240 * MiB, WS_END = 256 * MiB;
static_assert(WS_WIN + (size_t)DEPTH * NINP * DM * 2 <= WS_WOUT && WS_WGU + (size_t)DEPTH * NGU * DM * 2 <= WS_WD && WS_WD + (size_t)DEPTH * DM * DFF * 2 <= WS_WPU, "ws map");
static_assert(WS_PROJ + (size_t)6 * M * 512 * 2 <= WS_ACT && WS_HFF + (size_t)M * DFF * 2 <= WS_ACT && WS_MISC + (size_t)M * 256 * 4 <= WS_END, "ws map");
constexpr int CW_BAR = 4096;

constexpr int RING_OFF = 0, RING_BYTES = 131072;
constexpr int LDSCTL_OFF = RING_BYTES, MISC_OFF = LDSCTL_OFF + 320;
constexpr int LDS_BYTES = 147456;

#define GAS __attribute__((address_space(1)))
#define LAS __attribute__((address_space(3)))
typedef unsigned short bf16;
typedef unsigned v4u __attribute__((ext_vector_type(4)));
typedef unsigned v2u __attribute__((ext_vector_type(2)));
typedef float f32x4 __attribute__((ext_vector_type(4)));
typedef short bf16x8 __attribute__((ext_vector_type(8)));
typedef GAS unsigned gu32;
#define RLX_AGENT __ATOMIC_RELAXED, __HIP_MEMORY_SCOPE_AGENT
#define LDS_WAIT() asm volatile("s_waitcnt lgkmcnt(0)" ::: "memory")
#define VM_WAIT() asm volatile("s_waitcnt vmcnt(0)" ::: "memory")
__device__ __forceinline__ unsigned f2bf(float f) { unsigned u = __builtin_bit_cast(unsigned, f); return (u + 0x7fffu + ((u >> 16) & 1u)) >> 16; }
__device__ __forceinline__ unsigned pk2(float lo, float hi) { return f2bf(lo) | (f2bf(hi) << 16); }
using pg8::bf_lo; using pg8::bf_hi;

#define XB_TMO      128
#define XB_XCNT(j)  (256  + 64 * (j))
#define XB_XSUB(j)  (1280 + 64 * (j))
#define XB_XGEN(j)  (2304 + 64 * (j))
#define XB_TOP      3328
#define XB_TOPGEN   3392
#define XCD_BAR_WORDS 3456
#define XB_SPIN_CAP (1u << 18)

__device__ __forceinline__ unsigned xb_ld(unsigned* p)              { return __hip_atomic_load(p, __ATOMIC_RELAXED, __HIP_MEMORY_SCOPE_AGENT); }
__device__ __forceinline__ unsigned xb_add(unsigned* p, unsigned v) { return __hip_atomic_fetch_add(p, v, __ATOMIC_RELAXED, __HIP_MEMORY_SCOPE_AGENT); }
__device__ __forceinline__ unsigned xb_xcc_id() { return (unsigned)__builtin_amdgcn_s_getreg((3 << 11) | 20) & 0xFu; }
#define XB_SPIN(cond, bar) do { unsigned _sp = 0; while (cond) { __builtin_amdgcn_s_sleep(1); \
    if ((++_sp & 255u) == 0u) { if (xb_ld(&(bar)[XB_TMO])) break; if (_sp > XB_SPIN_CAP) { atomicAdd(&(bar)[XB_TMO], 1u); break; } } } } while (0)

struct XcdBarrier {
    unsigned* bar; unsigned x;
    volatile LAS unsigned* st;
};

__device__ __forceinline__ XcdBarrier xcd_barrier_post(unsigned* bar, volatile LAS unsigned* st) {
    XcdBarrier b; b.bar = bar; b.x = xb_xcc_id(); b.st = st;
    if (threadIdx.x == 0) (void)xb_add(&bar[XB_XCNT(b.x)], 1u);
    return b;
}
__device__ __forceinline__ void xcd_barrier_complete(unsigned* bar, unsigned x, unsigned& nloc, unsigned& nx) {
    const unsigned G = gridDim.x * gridDim.y * gridDim.z;
    unsigned sum, cnt, mine, sp = 0u;
    for (;;) {
        sum = 0u; cnt = 0u; mine = 0u;
#pragma unroll
        for (unsigned j = 0; j < 16; ++j) { const unsigned c = xb_ld(&bar[XB_XCNT(j)]); sum += c; cnt += (c > 0u) ? 1u : 0u; mine = (j == x) ? c : mine; }
        if (sum == G) break;
        __builtin_amdgcn_s_sleep(1);
        if ((++sp & 255u) == 0u) { if (xb_ld(&bar[XB_TMO])) break; if (sp > XB_SPIN_CAP) { atomicAdd(&bar[XB_TMO], 1u); break; } }
    }
    nloc = mine > 0u ? mine : 1u; nx = cnt > 0u ? cnt : 1u;
}

__device__ __forceinline__ void xcd_barrier(const XcdBarrier& b) {
    asm volatile("s_waitcnt vmcnt(0)" ::: "memory");
    __syncthreads();
    if (threadIdx.x == 0) {
        unsigned* bar = b.bar;
        __builtin_amdgcn_s_waitcnt(0);
        unsigned nloc = b.st[0], nx = b.st[1];
        if (nloc == 0u) { xcd_barrier_complete(bar, b.x, nloc, nx); b.st[0] = nloc; b.st[1] = nx; }
        const unsigned old = xb_add(&bar[XB_XSUB(b.x)], 1u);
        const unsigned gen = old / nloc;
        if (old + 1u == (gen + 1u) * nloc) {
            __builtin_amdgcn_fence(__ATOMIC_RELEASE, "agent");
            asm volatile("s_waitcnt vmcnt(0)" ::: "memory");
            const unsigned og = xb_add(&bar[XB_TOP], 1u);
            const unsigned tg = og / nx;
            if (og + 1u == (tg + 1u) * nx) xb_add(&bar[XB_TOPGEN], 1u);
            else XB_SPIN(xb_ld(&bar[XB_TOPGEN]) == tg, bar);
            __builtin_amdgcn_fence(__ATOMIC_ACQUIRE, "agent");
            xb_add(&bar[XB_XGEN(b.x)], 1u);
            asm volatile("s_waitcnt vmcnt(0)" ::: "memory");
        } else {
            XB_SPIN(xb_ld(&bar[XB_XGEN(b.x)]) == gen, bar);
            __builtin_amdgcn_fence(__ATOMIC_ACQUIRE, "agent");
            asm volatile("s_waitcnt vmcnt(0)" ::: "memory");
        }
    }
    __syncthreads();
}

struct Frame {
    LAS unsigned char* lds;
    volatile LAS unsigned* MISC;
    gu32* ctl;
    int tid, lane, wave, G;
    float* out; unsigned char* ws;
};
struct Args { const void* in[22]; float* out; unsigned char* ws; int ph_lo, ph_hi; };
#define INP(k) ((const float*)A.in[k])
#define IN_X 0
#define IN_P 1
#define IN_POS 2
#define IN_PREMIX 3
#define IN_WIN 4
#define IN_RETG 5
#define IN_RETB 6
#define IN_KVG 7
#define IN_IKG 8
#define IN_IKB 9
#define IN_WUK 10
#define IN_WUV 11
#define IN_WOUT 12
#define IN_POSTMIX 13
#define IN_PREFFN 14
#define IN_WGATE 15
#define IN_WUP 16
#define IN_WDOWN 17
#define IN_POSTFFN 18
#define IN_WPU 19
#define IN_WPG 20
#define IN_PLEG 21

__device__ __forceinline__ float wave_sum(float v) {
#pragma unroll
    for (int o = 1; o < 64; o <<= 1) v += __shfl_xor(v, o);
    return v;
}
__device__ __forceinline__ float wave_max(float v) {
#pragma unroll
    for (int o = 1; o < 64; o <<= 1) v = fmaxf(v, __shfl_xor(v, o));
    return v;
}
__device__ __forceinline__ float wave_min(float v) {
#pragma unroll
    for (int o = 1; o < 64; o <<= 1) v = fminf(v, __shfl_xor(v, o));
    return v;
}
__device__ __forceinline__ int wave_sum_i(int v) {
#pragma unroll
    for (int o = 1; o < 64; o <<= 1) v += __shfl_xor(v, o);
    return v;
}

__device__ __forceinline__ int dest_row(int mode, int n) {
    if (mode == 0) return n;
    if (mode == 2) return 8 * (n >> 2) + (n & 3);
    if (mode == 3) return 8 * (n >> 2) + 4 + (n & 3);
    if (n < 1024) { const int d = n & 63, base = n & ~63; return d < 32 ? base + 8 * (d >> 2) + (d & 3) : base + 8 * ((d - 32) >> 2) + 4 + (d & 3); }
    if (n < 2560) return n;
    if (n < 2688) return 3072 + (n - 2560);
    if (n < 3200) return 2560 + (n - 2688);
    return n;
}
__device__ __forceinline__ void transpose_item(const float* W, int K, int N, bf16* WT, int mode, LAS float* scr, int item, int lane) {
    const int nblk = (N + 31) / 32, kb = item / nblk, nb = item % nblk, k0 = 64 * kb, n0 = 32 * nb;
    const int nn = n0 + (lane & 31);
#pragma unroll 8
    for (int i = 0; i < 32; ++i) { const int kk = 2 * i + (lane >> 5); scr[kk * 33 + (lane & 31)] = (nn < N) ? W[(size_t)(k0 + kk) * N + nn] : 0.f; }
    LDS_WAIT(); asm volatile("" ::: "memory");
    const int c = lane & 7;
#pragma unroll
    for (int j = 0; j < 4; ++j) { const int nl = (lane >> 3) + 8 * j; const LAS float* s = scr + (8 * c) * 33 + nl;
        v4u o; o.x = pk2(s[0 * 33], s[1 * 33]); o.y = pk2(s[2 * 33], s[3 * 33]); o.z = pk2(s[4 * 33], s[5 * 33]); o.w = pk2(s[6 * 33], s[7 * 33]);
        if (n0 + nl < N) *(GAS v4u*)(WT + (size_t)dest_row(mode, n0 + nl) * K + k0 + 8 * c) = o; }
    LDS_WAIT(); asm volatile("" ::: "memory");
}
__device__ __forceinline__ void norm_row(int lane, const float* tmp, const float* xin, float* xout, const float* g_post, const float* g_next, bf16* act, bool plain) {
    f32x4 x[4];
#pragma unroll
    for (int j = 0; j < 4; ++j) x[j] = ((const GAS f32x4*)xin)[lane + 64 * j];
    if (tmp) {
        f32x4 t[4]; float ss = 0.f;
#pragma unroll
        for (int j = 0; j < 4; ++j) { t[j] = ((const GAS f32x4*)tmp)[lane + 64 * j]; ss += (t[j].x * t[j].x + t[j].y * t[j].y) + (t[j].z * t[j].z + t[j].w * t[j].w); }
        const float r = 1.0f / sqrtf(wave_sum(ss) * (1.f / DM) + EPS);
#pragma unroll
        for (int j = 0; j < 4; ++j) { const f32x4 g = ((const GAS f32x4*)g_post)[lane + 64 * j]; x[j] = x[j] + t[j] * r * g; }
    }
    if (xout) {
#pragma unroll
        for (int j = 0; j < 4; ++j) ((GAS f32x4*)xout)[lane + 64 * j] = x[j];
    }
    if (act) {
        if (g_next) {
            float ss = 0.f;
#pragma unroll
            for (int j = 0; j < 4; ++j) ss += (x[j].x * x[j].x + x[j].y * x[j].y) + (x[j].z * x[j].z + x[j].w * x[j].w);
            const float r = 1.0f / sqrtf(wave_sum(ss) * (1.f / DM) + EPS);
#pragma unroll
            for (int j = 0; j < 4; ++j) { const f32x4 g = ((const GAS f32x4*)g_next)[lane + 64 * j]; x[j] = x[j] * r * g; }
        }
        (void)plain;
#pragma unroll
        for (int j = 0; j < 4; ++j) { v2u o; o.x = pk2(x[j].x, x[j].y); o.y = pk2(x[j].z, x[j].w); ((GAS v2u*)act)[lane + 64 * j] = o; }
    }
}

__device__ __forceinline__ void p0_prologue(Frame& F, const Args& A) {
    LAS float* scr = (LAS float*)(F.lds + RING_OFF + F.wave * 16384);
    const int gw = blockIdx.x * NWAVES + F.wave, NGW = F.G * NWAVES;
    const int gt = blockIdx.x * NTHREADS + F.tid, NGT = F.G * NTHREADS;
    unsigned char* ws = F.ws;
    for (int l = 0; l < DEPTH; ++l) {
        for (int mat = 0; mat < 7; ++mat) {
            const float* W; int K, N, mode; bf16* WT;
            switch (mat) {
                case 0: W = INP(IN_WIN) + (size_t)l * DM * NIN; K = DM; N = NIN; mode = 1; WT = (bf16*)(ws + WS_WIN) + (size_t)l * NINP * DM; break;
                case 1: W = INP(IN_WOUT) + (size_t)l * DM * DM; K = DM; N = DM; mode = 0; WT = (bf16*)(ws + WS_WOUT) + (size_t)l * DM * DM; break;
                case 2: W = INP(IN_WGATE) + (size_t)l * DM * DFF; K = DM; N = DFF; mode = 2; WT = (bf16*)(ws + WS_WGU) + (size_t)l * NGU * DM; break;
                case 3: W = INP(IN_WUP) + (size_t)l * DM * DFF; K = DM; N = DFF; mode = 3; WT = (bf16*)(ws + WS_WGU) + (size_t)l * NGU * DM; break;
                case 4: W = INP(IN_WDOWN) + (size_t)l * DFF * DM; K = DFF; N = DM; mode = 0; WT = (bf16*)(ws + WS_WD) + (size_t)l * DM * DFF; break;
                case 5: W = INP(IN_WPU) + (size_t)l * PLE * DM; K = PLE; N = DM; mode = 0; WT = (bf16*)(ws + WS_WPU) + (size_t)l * DM * PLE; break;
                default: W = INP(IN_WPG) + (size_t)l * DM * DM; K = DM; N = DM; mode = 0; WT = (bf16*)(ws + WS_WPG) + (size_t)l * DM * DM; break;
            }
            const int nitems = (K / 64) * ((N + 31) / 32);
            for (int it = gw; it < nitems; it += NGW) transpose_item(W, K, N, WT, mode, scr, it, F.lane);
        }
        for (int hd = 0; hd < 8; ++hd) {
            for (int it = gw; it < 8; it += NGW) {
                if (it < 4) transpose_item(INP(IN_WUK) + (size_t)(l * 8 + hd) * 64 * 128, 64, 128, (bf16*)(ws + WS_WUK) + (size_t)(l * 8 + hd) * 128 * 64, 0, scr, it, F.lane);
                else transpose_item(INP(IN_WUV) + (size_t)(l * 8 + hd) * 128 * 64, 128, 64, (bf16*)(ws + WS_WUV) + (size_t)(l * 8 + hd) * 64 * 128, 0, scr, it - 4, F.lane);
            }
        }
        { GAS v4u* z = (GAS v4u*)((bf16*)(ws + WS_WIN) + (size_t)l * NINP * DM + (size_t)NIN * DM); const int n16 = (NINP - NIN) * DM * 2 / 16;
          for (int i = gt; i < n16; i += NGT) z[i] = (v4u){0u, 0u, 0u, 0u}; }
    }
    { const GAS f32x4* src = (const GAS f32x4*)INP(IN_P); GAS v4u* dst = (GAS v4u*)(ws + WS_PB); const int n8 = DEPTH * M * PLE / 8;
      for (int i = gt; i < n8; i += NGT) { const f32x4 a = src[2 * i], b = src[2 * i + 1]; v4u o; o.x = pk2(a.x, a.y); o.y = pk2(a.z, a.w); o.z = pk2(b.x, b.y); o.w = pk2(b.z, b.w); dst[i] = o; } }
    { const int* pos = (const int*)INP(IN_POS); float* ct = (float*)(ws + WS_COS); float* st = (float*)(ws + WS_SIN);
      for (int i = gt; i < M * 32; i += NGT) { const int row = i >> 5, j = i & 31; const double inv = exp(-(double)j * (9.210340371976184 / 32.0)); const double ang = (double)pos[row] * inv;
          ct[i] = (float)cos(ang); st[i] = (float)sin(ang); } }
    for (int m = gw; m < M; m += NGW) norm_row(F.lane, nullptr, INP(IN_X) + (size_t)m * DM, nullptr, nullptr, INP(IN_PREMIX), (bf16*)(ws + WS_ACT) + (size_t)m * DM, false);
}

__device__ __forceinline__ void postproj_phase(Frame& F, const Args& A, int l) {
    const int gw = blockIdx.x * NWAVES + F.wave, NGW = F.G * NWAVES, lane = F.lane;
    const float* misc = (const float*)(F.ws + WS_MISC);
    bf16* ckv = (bf16*)(F.ws + WS_CKV); bf16* ki = (bf16*)(F.ws + WS_KI); float* wi = (float*)(F.ws + WS_WI);
    const float* kvg = INP(IN_KVG) + l * 128; const float* ikg = INP(IN_IKG) + l * 64; const float* ikb = INP(IN_IKB) + l * 64;
    for (int m = gw; m < M; m += NGW) {
        const f32x4 v = ((const GAS f32x4*)(misc + (size_t)m * 256))[lane];
        const float sq = (v.x * v.x + v.y * v.y) + (v.z * v.z + v.w * v.w), sm = (v.x + v.y) + (v.z + v.w);
        const bool isk = (lane >= 32 && lane < 48);
        const float ssc = wave_sum(lane < 32 ? sq : 0.f);
        const float mu = wave_sum(isk ? sm : 0.f) * (1.f / 64.f);
        const f32x4 dv = v - mu;
        const float var = wave_sum(isk ? ((dv.x * dv.x + dv.y * dv.y) + (dv.z * dv.z + dv.w * dv.w)) : 0.f) * (1.f / 64.f);
        if (lane < 32) { const float r = 1.0f / sqrtf(ssc * (1.f / 128.f) + EPS); const f32x4 g = *(const f32x4*)(kvg + 4 * lane); const f32x4 o = v * r * g;
            v2u w; w.x = pk2(o.x, o.y); w.y = pk2(o.z, o.w); ((GAS v2u*)(ckv + (size_t)m * 128))[lane] = w; }
        else if (isk) { const float r = 1.0f / sqrtf(var + EPS); const int d = 4 * (lane - 32); const f32x4 g = *(const f32x4*)(ikg + d), bb = *(const f32x4*)(ikb + d); const f32x4 o = dv * r * g + bb;
            v2u w; w.x = pk2(o.x, o.y); w.y = pk2(o.z, o.w); ((GAS v2u*)(ki + (size_t)m * 64))[lane - 32] = w; }
        else if (lane < 50) { ((GAS f32x4*)(wi + (size_t)m * 8))[lane - 48] = v * 0.04419417382415922f; }
    }
}

__device__ __forceinline__ void ret_naive_phase(Frame& F, const Args& A, int l) {
    LAS float* Ks = (LAS float*)(F.lds + RING_OFF); LAS float* Vs = Ks + 32 * 64;
    const bf16* RQ = (const bf16*)(F.ws + WS_PROJ); const bf16* RK = RQ + (size_t)M * 512; const bf16* RV = RK + (size_t)M * 512; const bf16* RG = RV + (size_t)M * 512;
    bf16* CAT = (bf16*)(F.ws + WS_CAT);
    const int tid = F.tid;
    for (int item = blockIdx.x; item < 256; item += F.G) {
        const int b = item >> 5, h = (item >> 2) & 7, tq = item & 3;
        const int t = 4 * tid + tq; const size_t row = (size_t)b * SEQ + t;
        float q[64], acc[64];
#pragma unroll
        for (int c = 0; c < 8; ++c) { const v4u w = *(const GAS v4u*)(RQ + row * 512 + h * 64 + c * 8);
            q[8 * c + 0] = bf_lo(w.x); q[8 * c + 1] = bf_hi(w.x); q[8 * c + 2] = bf_lo(w.y); q[8 * c + 3] = bf_hi(w.y); q[8 * c + 4] = bf_lo(w.z); q[8 * c + 5] = bf_hi(w.z); q[8 * c + 6] = bf_lo(w.w); q[8 * c + 7] = bf_hi(w.w); }
#pragma unroll
        for (int e = 0; e < 64; ++e) acc[e] = 0.f;
        const float lg2 = log2f(1.0f - exp2f(-5.0f - (float)h));
        for (int s0 = 0; s0 < SEQ; s0 += 32) {
            __syncthreads();
            { const int which = tid >> 8, r = (tid & 255) >> 3, c8 = tid & 7; const bf16* src = (which ? RV : RK) + ((size_t)b * SEQ + s0 + r) * 512 + h * 64 + c8 * 8;
              const v4u w = *(const GAS v4u*)src; LAS float* d = (which ? Vs : Ks) + r * 64 + c8 * 8;
              d[0] = bf_lo(w.x); d[1] = bf_hi(w.x); d[2] = bf_lo(w.y); d[3] = bf_hi(w.y); d[4] = bf_lo(w.z); d[5] = bf_hi(w.z); d[6] = bf_lo(w.w); d[7] = bf_hi(w.w); }
            __syncthreads();
            for (int s = 0; s < 32; ++s) { const int sg = s0 + s;
                if (sg <= t) { float dot = 0.f;
#pragma unroll
                    for (int d = 0; d < 64; ++d) dot += q[d] * Ks[s * 64 + d];
                    const float w = dot * exp2f(lg2 * (float)(t - sg));
#pragma unroll
                    for (int e = 0; e < 64; ++e) acc[e] += w * Vs[s * 64 + e]; } }
        }
        float mu = 0.f;
#pragma unroll
        for (int e = 0; e < 64; ++e) mu += acc[e];
        mu *= (1.f / 64.f); float var = 0.f;
#pragma unroll
        for (int e = 0; e < 64; ++e) { const float d = acc[e] - mu; var += d * d; }
        const float r = 1.0f / sqrtf(var * (1.f / 64.f) + EPS);
        const float* g = INP(IN_RETG) + (l * 8 + h) * 64; const float* bb = INP(IN_RETB) + (l * 8 + h) * 64;
#pragma unroll
        for (int c = 0; c < 8; ++c) { const v4u gw = *(const GAS v4u*)(RG + row * 512 + h * 64 + c * 8); float y[8];
#pragma unroll
            for (int i = 0; i < 8; ++i) y[i] = (acc[8 * c + i] - mu) * r * g[8 * c + i] + bb[8 * c + i];
            v4u o; o.x = pk2(bf_lo(gw.x) * y[0], bf_hi(gw.x) * y[1]); o.y = pk2(bf_lo(gw.y) * y[2], bf_hi(gw.y) * y[3]); o.z = pk2(bf_lo(gw.z) * y[4], bf_hi(gw.z) * y[5]); o.w = pk2(bf_lo(gw.w) * y[6], bf_hi(gw.w) * y[7]);
            *(GAS v4u*)(CAT + row * 1024 + h * 64 + c * 8) = o; }
    }
    __syncthreads();
}

__device__ __forceinline__ void dsa_naive_phase(Frame& F, const Args& A, int l) {
    LAS float* S = (LAS float*)(F.lds + RING_OFF) + F.wave * 4096;
    LAS float* qiS = S; LAS float* aqS = S + 512; LAS float* qlS = S + 1024; LAS unsigned* kuS = (LAS unsigned*)(S + 2048); LAS float* oS = S;
    const bf16* AQ = (const bf16*)(F.ws + WS_PROJ) + (size_t)4 * M * 512; const bf16* IQ = AQ + (size_t)M * 512;
    const bf16* CKV = (const bf16*)(F.ws + WS_CKV); const bf16* KI = (const bf16*)(F.ws + WS_KI); const float* WI = (const float*)(F.ws + WS_WI);
    const float* wuk = INP(IN_WUK) + (size_t)l * 8 * 64 * 128; const float* wuv = INP(IN_WUV) + (size_t)l * 8 * 128 * 64;
    bf16* CAT = (bf16*)(F.ws + WS_CAT);
    const int lane = F.lane;
    for (int gw = blockIdx.x * NWAVES + F.wave; gw < SEQ; gw += F.G * NWAVES)
    for (int k = 0; k < BATCH; ++k) {
        const int b = k, t = (k & 1) ? (SEQ - 1 - gw) : gw; const size_t row = (size_t)b * SEQ + t;
        { const v4u w = *(const GAS v4u*)(IQ + row * 512 + 8 * lane); LAS float* d = qiS + 8 * lane;
          d[0] = bf_lo(w.x); d[1] = bf_hi(w.x); d[2] = bf_lo(w.y); d[3] = bf_hi(w.y); d[4] = bf_lo(w.z); d[5] = bf_hi(w.z); d[6] = bf_lo(w.w); d[7] = bf_hi(w.w);
          const v4u a = *(const GAS v4u*)(AQ + row * 512 + 8 * lane); LAS float* e = aqS + 8 * lane;
          e[0] = bf_lo(a.x); e[1] = bf_hi(a.x); e[2] = bf_lo(a.y); e[3] = bf_hi(a.y); e[4] = bf_lo(a.z); e[5] = bf_hi(a.z); e[6] = bf_lo(a.w); e[7] = bf_hi(a.w); }
        const float wiv = WI[row * 8 + (lane & 7)];
        LDS_WAIT(); asm volatile("" ::: "memory");
        for (int h = 0; h < 8; ++h) { float a0 = 0.f, a1 = 0.f;
            for (int d = 0; d < 64; ++d) { const float a = aqS[h * 64 + d]; const float* wr_ = wuk + ((size_t)h * 64 + d) * 128; a0 += a * wr_[lane]; a1 += a * wr_[64 + lane]; }
            qlS[h * 128 + lane] = a0 * 0.125f; qlS[h * 128 + 64 + lane] = a1 * 0.125f; }
        for (int i = 0; i < 32; ++i) kuS[lane + 64 * i] = 0u;
        LDS_WAIT(); asm volatile("" ::: "memory");
        for (int i = 0; 64 * i <= t; ++i) { const int s = lane + 64 * i; const bf16* kr = KI + ((size_t)b * SEQ + s) * 64; float kf[64];
#pragma unroll
            for (int c = 0; c < 8; ++c) { const v4u w = *(const GAS v4u*)(kr + 8 * c);
                kf[8 * c + 0] = bf_lo(w.x); kf[8 * c + 1] = bf_hi(w.x); kf[8 * c + 2] = bf_lo(w.y); kf[8 * c + 3] = bf_hi(w.y); kf[8 * c + 4] = bf_lo(w.z); kf[8 * c + 5] = bf_hi(w.z); kf[8 * c + 6] = bf_lo(w.w); kf[8 * c + 7] = bf_hi(w.w); }
            float tot = 0.f;
            for (int h = 0; h < 8; ++h) { float dot = 0.f;
#pragma unroll
                for (int d = 0; d < 64; ++d) dot += qiS[h * 64 + d] * kf[d];
                tot += __shfl(wiv, h) * fmaxf(dot, 0.f); }
            const float v = tot + 0.0f; const unsigned u = __float_as_uint(v);
            if (s <= t) kuS[s] = (u & 0x80000000u) ? ~u : (u | 0x80000000u); }
        LDS_WAIT(); asm volatile("" ::: "memory");
        unsigned ku[32];
#pragma unroll
        for (int i = 0; i < 32; ++i) ku[i] = kuS[lane + 64 * i];
        const int kk = (t + 1 < 256) ? (t + 1) : 256;
        unsigned thr = 0u, tiekey = 0u; int need = 0;
        if (t + 1 > 256) {
            unsigned lo = 0u, hi = 0xFFFFFFFFu; bool exact = false;
            while (hi - lo > 1u) {
                const unsigned mid = lo + ((hi - lo) >> 1);
                int c = 0;
#pragma unroll
                for (int i = 0; i < 32; ++i) c += (ku[i] > mid) ? 1 : 0;
                c = wave_sum_i(c);
                if (c == kk) { thr = mid; exact = true; break; }
                if (c > kk) lo = mid; else hi = mid;
            }
            if (!exact) { int c = 0;
#pragma unroll
                for (int i = 0; i < 32; ++i) c += (ku[i] > hi) ? 1 : 0;
                c = wave_sum_i(c); thr = hi; tiekey = hi; need = kk - c; }
        }
        unsigned selm = 0u; int run = 0;
#pragma unroll
        for (int i = 0; i < 32; ++i) {
            bool sl = ku[i] > thr;
            if (need > 0) { const bool tie = (ku[i] == tiekey); const unsigned long long tb = __ballot(tie);
                const int rank = run + __popcll(tb & ((1ull << lane) - 1ull)); if (tie && rank < need) sl = true; run += __popcll(tb); }
            selm |= sl ? (1u << i) : 0u;
        }
        LAS float* pS = (LAS float*)kuS;
        for (int h = 0; h < 8; ++h) {
            float mx = -INFINITY;
            for (int i = 0; 64 * i <= t; ++i) { float dot = -INFINITY;
                if ((selm >> i) & 1u) { const int s = lane + 64 * i; const bf16* cr = CKV + ((size_t)b * SEQ + s) * 128; dot = 0.f;
#pragma unroll 4
                    for (int c4 = 0; c4 < 16; ++c4) { const v4u w = *(const GAS v4u*)(cr + 8 * c4); const LAS float* qq = qlS + h * 128 + 8 * c4;
                        dot += qq[0] * bf_lo(w.x) + qq[1] * bf_hi(w.x) + qq[2] * bf_lo(w.y) + qq[3] * bf_hi(w.y) + qq[4] * bf_lo(w.z) + qq[5] * bf_hi(w.z) + qq[6] * bf_lo(w.w) + qq[7] * bf_hi(w.w); }
                    mx = fmaxf(mx, dot); }
                pS[lane + 64 * i] = dot; }
            mx = wave_max(mx);
            float sum = 0.f;
            for (int i = 0; 64 * i <= t; ++i) { const float lgv = pS[lane + 64 * i]; const float p = ((selm >> i) & 1u) ? __expf(lgv - mx) : 0.f; pS[lane + 64 * i] = p; sum += p; }
            sum = wave_sum(sum);
            LDS_WAIT(); asm volatile("" ::: "memory");
            float o0 = 0.f, o1 = 0.f;
            for (int i = 0; 64 * i <= t; ++i) { unsigned long long mbits = __ballot((selm >> i) & 1u);
                while (mbits) { const int bit = __ffsll((long long)mbits) - 1; mbits &= mbits - 1ull; const float ps = pS[bit + 64 * i];
                    const unsigned w = ((const GAS unsigned*)(CKV + ((size_t)b * SEQ + bit + 64 * i) * 128))[lane]; o0 += ps * bf_lo(w); o1 += ps * bf_hi(w); } }
            LDS_WAIT(); asm volatile("" ::: "memory");
            const float inv = 1.0f / sum;
            oS[h * 128 + 2 * lane] = o0 * inv; oS[h * 128 + 2 * lane + 1] = o1 * inv;
        }
        LDS_WAIT(); asm volatile("" ::: "memory");
        for (int h = 0; h < 8; ++h) { float a = 0.f;
            for (int c = 0; c < 128; ++c) a += oS[h * 128 + c] * wuv[((size_t)h * 128 + c) * 64 + lane];
            CAT[row * 1024 + 512 + h * 64 + lane] = (bf16)f2bf(a); }
        LDS_WAIT(); asm volatile("" ::: "memory");
    }
}

__device__ __forceinline__ void norm_phase(Frame& F, const float* tmp, const float* xin, float* xout, const float* g_post, const float* g_next, bf16* act) {
    const int gw = blockIdx.x * NWAVES + F.wave, NGW = F.G * NWAVES;
    for (int m = gw; m < M; m += NGW) norm_row(F.lane, tmp + (size_t)m * DM, xin + (size_t)m * DM, xout + (size_t)m * DM, g_post, g_next, act ? act + (size_t)m * DM : nullptr, false);
}

typedef float f32x16 __attribute__((ext_vector_type(16)));
typedef short v4i16_t __attribute__((ext_vector_type(4)));
#define MFMA32(a, b, c) __builtin_amdgcn_mfma_f32_32x32x16_bf16((a), (b), (c), 0, 0, 0)
__device__ __forceinline__ unsigned off_b(unsigned row, unsigned ch) { return 256u * row + 16u * (ch ^ (((row & 3) << 2) | ((row >> 2) & 3))); }
__device__ __forceinline__ unsigned row_read_addr(unsigned lane, unsigned s) { return off_b(lane & 31, 2 * s + (lane >> 5)); }
__device__ __forceinline__ unsigned tr_read_addr_acc(unsigned lane, unsigned c, unsigned rbase) {
    const unsigned h = lane >> 5, blk = (lane >> 4) & 1, q = (lane & 15) >> 2, p = lane & 3;
    return off_b(rbase + 4 * h + q, 4 * c + 2 * blk + (p >> 1)) + 8 * (p & 1);
}
__device__ __forceinline__ v4i16_t lds_tr(LAS unsigned char* p) { return __builtin_amdgcn_ds_read_tr16_b64_v4i16((LAS v4i16_t*)p); }
__device__ __forceinline__ unsigned cvtpk(float lo, float hi) { typedef float f2 __attribute__((ext_vector_type(2))); typedef __bf16 b2 __attribute__((ext_vector_type(2))); f2 v = {lo, hi}; b2 b = __builtin_convertvector(v, b2); return __builtin_bit_cast(unsigned, b); }
__device__ __forceinline__ float xhalf_max(float v) { auto rr = __builtin_amdgcn_permlane32_swap(__float_as_uint(v), __float_as_uint(v), false, false); return fmaxf(__uint_as_float(rr[0]), __uint_as_float(rr[1])); }
__device__ __forceinline__ float xhalf_sum(float v) { auto rr = __builtin_amdgcn_permlane32_swap(__float_as_uint(v), __float_as_uint(v), false, false); return __uint_as_float(rr[0]) + __uint_as_float(rr[1]); }
__device__ __forceinline__ int half_sum_i(int v) {
#pragma unroll
    for (int o = 1; o < 32; o <<= 1) v += __shfl_xor(v, o);
    return v;
}
__device__ __forceinline__ unsigned mono_key(float s) { const float v = s + 0.0f; const unsigned u = __float_as_uint(v); return (u & 0x80000000u) ? ~u : (u | 0x80000000u); }

__device__ __forceinline__ int launder(int x) { asm volatile("" : "+v"(x)); return x; }
constexpr int DSA_QL = 0;
constexpr int DSA_MASK = 65536;
constexpr int DSA_CT = 73728;
constexpr float LOG2E = 1.4426950408889634f;

__device__ __forceinline__ void dsa_item(Frame& F, const Args& A, const int l, const int b, const int qt) {
    const int w = F.wave;
    const int t0 = 32 * qt; const size_t rowbase = (size_t)b * SEQ;
    LAS unsigned char* lds = F.lds + RING_OFF;
    const bf16* AQ = (const bf16*)(F.ws + WS_PROJ) + (size_t)4 * M * 512; const bf16* IQ = AQ + (size_t)M * 512;
    const bf16* CKV = (const bf16*)(F.ws + WS_CKV); const bf16* KI = (const bf16*)(F.ws + WS_KI); const float* WI = (const float*)(F.ws + WS_WI);
    const bf16* WUKT = (const bf16*)(F.ws + WS_WUK) + (size_t)l * 8 * 128 * 64; const bf16* WUVT = (const bf16*)(F.ws + WS_WUV) + (size_t)l * 8 * 64 * 128;
    bf16* CAT = (bf16*)(F.ws + WS_CAT);
    LAS unsigned* MASK = (LAS unsigned*)(lds + DSA_MASK);

    {
        const int lane = launder(F.lane), r = lane & 31, hh = lane >> 5;
        bf16x8 bq[4];
#pragma unroll
        for (int ks = 0; ks < 4; ++ks) bq[ks] = *(const GAS bf16x8*)(AQ + (rowbase + t0 + r) * 512 + w * 64 + 16 * ks + 8 * hh);
#pragma unroll
        for (int cb = 0; cb < 4; ++cb) {
            f32x16 acc = {};
#pragma unroll
            for (int ks = 0; ks < 4; ++ks) { const bf16x8 af = *(const GAS bf16x8*)(WUKT + ((size_t)(w * 128 + 32 * cb + r)) * 64 + 16 * ks + 8 * hh); acc = MFMA32(af, bq[ks], acc); }
            const int q = r; LAS unsigned char* rowp = lds + DSA_QL + 8192 * (q >> 2);
            const unsigned n = (unsigned)((q & 3) * 8 + w);
#pragma unroll
            for (int rg = 0; rg < 4; ++rg) { v2u o; o.x = cvtpk(acc[4 * rg] * (0.125f * LOG2E), acc[4 * rg + 1] * (0.125f * LOG2E)); o.y = cvtpk(acc[4 * rg + 2] * (0.125f * LOG2E), acc[4 * rg + 3] * (0.125f * LOG2E));
                *(LAS v2u*)(rowp + off_b(n, 4 * cb + rg) + 8 * hh) = o; }
        }
    }
    __syncthreads();

    {
        const int lane = launder(F.lane), r = lane & 31, hh = lane >> 5;
        const int ql_a = 2 * ((r >> 2) & 1) + (r >> 4), hd_a = 4 * ((r >> 3) & 1) + (r & 3);
        bf16x8 aiq[4];
#pragma unroll
        for (int ks = 0; ks < 4; ++ks) aiq[ks] = *(const GAS bf16x8*)(IQ + (rowbase + t0 + 4 * w + ql_a) * 512 + hd_a * 64 + 16 * ks + 8 * hh);
        float wv[16];
#pragma unroll
        for (int a = 0; a < 2; ++a) { const GAS f32x4* wp = (const GAS f32x4*)(WI + (rowbase + t0 + 4 * w + 2 * hh + a) * 8); const f32x4 w0 = wp[0], w1 = wp[1];
            wv[8 * a + 0] = w0.x; wv[8 * a + 1] = w0.y; wv[8 * a + 2] = w0.z; wv[8 * a + 3] = w0.w; wv[8 * a + 4] = w1.x; wv[8 * a + 5] = w1.y; wv[8 * a + 6] = w1.z; wv[8 * a + 7] = w1.w; }
        unsigned ku[2][64];
        const int tq0 = t0 + 4 * w + 2 * hh;
        bf16x8 bk[4];
#pragma unroll
        for (int ks = 0; ks < 4; ++ks) bk[ks] = *(const GAS bf16x8*)(KI + (rowbase + r) * 64 + 16 * ks + 8 * hh);
#pragma unroll
        for (int kb = 0; kb < 64; ++kb) {
            ku[0][kb] = 0u; ku[1][kb] = 0u;
            if (kb <= qt) {
                bf16x8 bn[4];
                const int kbn = (kb < qt) ? kb + 1 : kb;
#pragma unroll
                for (int ks = 0; ks < 4; ++ks) bn[ks] = *(const GAS bf16x8*)(KI + (rowbase + 32 * kbn + r) * 64 + 16 * ks + 8 * hh);
                f32x16 acc = {};
#pragma unroll
                for (int ks = 0; ks < 4; ++ks) acc = MFMA32(aiq[ks], bk[ks], acc);
                float s0 = 0.f, s1 = 0.f;
#pragma unroll
                for (int h = 0; h < 8; ++h) { s0 += wv[h] * fmaxf(acc[h], 0.f); s1 += wv[8 + h] * fmaxf(acc[8 + h], 0.f); }
                const int key = 32 * kb + r;
                unsigned k0 = (key <= tq0) ? mono_key(s0) : 0u, k1 = (key <= tq0 + 1) ? mono_key(s1) : 0u;
                asm volatile("" : "+v"(k0), "+v"(k1));
                ku[0][kb] = k0; ku[1][kb] = k1;
#pragma unroll
                for (int ks = 0; ks < 4; ++ks) bk[ks] = bn[ks];
                __builtin_amdgcn_sched_barrier(0);
            }
        }
        unsigned thr[2], tiek[2]; int need[2];
        {
            unsigned lo[2] = {0u, 0u}, hi[2] = {0xFFFFFFFFu, 0xFFFFFFFFu}; bool done[2]; int kk[2];
#pragma unroll
            for (int a = 0; a < 2; ++a) { const int t = tq0 + a; kk[a] = (t + 1 < 256) ? (t + 1) : 256; done[a] = (t + 1 <= 256); thr[a] = 0u; tiek[a] = 0u; need[a] = 0; }
            while (__any(!done[0] || !done[1])) {
                const unsigned m0 = lo[0] + ((hi[0] - lo[0]) >> 1), m1 = lo[1] + ((hi[1] - lo[1]) >> 1);
                int ca = 0, cb_ = 0;
#pragma unroll
                for (int kb = 0; kb < 64; ++kb) { ca += (ku[0][kb] > m0) ? 1 : 0; cb_ += (ku[1][kb] > m1) ? 1 : 0; }
                const int c = half_sum_i(ca + (cb_ << 16));
                const int c0 = c & 0xffff, c1 = c >> 16;
                if (!done[0]) { if (c0 == kk[0]) { thr[0] = m0; done[0] = true; } else if (c0 > kk[0]) lo[0] = m0; else hi[0] = m0;
                    if (!done[0] && hi[0] - lo[0] <= 1u) { done[0] = true; thr[0] = hi[0]; tiek[0] = hi[0]; need[0] = -1; } }
                if (!done[1]) { if (c1 == kk[1]) { thr[1] = m1; done[1] = true; } else if (c1 > kk[1]) lo[1] = m1; else hi[1] = m1;
                    if (!done[1] && hi[1] - lo[1] <= 1u) { done[1] = true; thr[1] = hi[1]; tiek[1] = hi[1]; need[1] = -1; } }
            }
            if (__any(need[0] < 0 || need[1] < 0)) {
                int ca = 0, cb_ = 0;
#pragma unroll
                for (int kb = 0; kb < 64; ++kb) { ca += (ku[0][kb] > thr[0]) ? 1 : 0; cb_ += (ku[1][kb] > thr[1]) ? 1 : 0; }
                const int c = half_sum_i(ca + (cb_ << 16));
                if (need[0] < 0) need[0] = kk[0] - (c & 0xffff);
                if (need[1] < 0) need[1] = kk[1] - (c >> 16);
            }
        }
        const bool anytie = __any(need[0] > 0 || need[1] > 0);
        int run0 = 0, run1 = 0;
        unsigned wq0[2] = {0u, 0u}, wq1[2] = {0u, 0u};
#pragma unroll
        for (int kb = 0; kb < 64; ++kb) {
            if (kb <= qt) {
                unsigned ka = ku[0][kb], kc = ku[1][kb];
                asm volatile("" : "+v"(ka), "+v"(kc));
                bool s0 = ka > thr[0], s1 = kc > thr[1];
                if (anytie) {
                    const bool t0b = (need[0] > 0) && (ka == tiek[0]), t1b = (need[1] > 0) && (kc == tiek[1]);
                    const unsigned long long b0 = __ballot(t0b), b1 = __ballot(t1b);
                    const unsigned h0 = hh ? (unsigned)(b0 >> 32) : (unsigned)b0, h1 = hh ? (unsigned)(b1 >> 32) : (unsigned)b1;
                    const unsigned below = (1u << r) - 1u;
                    if (t0b && run0 + __popc(h0 & below) < need[0]) s0 = true;
                    if (t1b && run1 + __popc(h1 & below) < need[1]) s1 = true;
                    run0 += __popc(h0); run1 += __popc(h1);
                }
                const unsigned long long m0 = __ballot(s0), m1 = __ballot(s1);
                const unsigned x0 = hh ? (unsigned)(m0 >> 32) : (unsigned)m0, x1 = hh ? (unsigned)(m1 >> 32) : (unsigned)m1;
                if (r == (kb & 31)) { wq0[kb >> 5] = x0; wq1[kb >> 5] = x1; }
            }
        }
#pragma unroll
        for (int j = 0; j < 2; ++j) { MASK[(4 * w + 2 * hh + 0) * 64 + 32 * j + r] = wq0[j]; MASK[(4 * w + 2 * hh + 1) * 64 + 32 * j + r] = wq1[j]; }
    }
    LDS_WAIT(); asm volatile("" ::: "memory");
    const int lane = launder(F.lane), r = lane & 31, hh = lane >> 5, tid = launder(F.tid);
    bf16x8 qf[8];
#pragma unroll
    for (int ks = 0; ks < 8; ++ks) qf[ks] = *(const LAS bf16x8*)(lds + DSA_QL + 8192 * w + row_read_addr(lane, ks));

    f32x16 o[4];
#pragma unroll
    for (int cb = 0; cb < 4; ++cb) o[cb] = (f32x16){};
    float mrun = -1e30f, lrun = 0.f;
    const LAS unsigned* mrow = MASK + (4 * w + (r >> 3)) * 64;
    {
        const int row = tid >> 4, ch = tid & 15;
        const v4u v = *(const GAS v4u*)(CKV + (rowbase + row) * 128 + 8 * ch);
        *(LAS v4u*)(lds + DSA_CT + off_b(row, ch)) = v;
    }
    __syncthreads();
    for (int kb = 0; kb <= qt; ++kb) {
        LAS unsigned char* ct = lds + DSA_CT + 8192 * (kb & 1);
        v4u nxt = {0u, 0u, 0u, 0u};
        if (kb < qt) { const int row = tid >> 4, ch = tid & 15; nxt = *(const GAS v4u*)(CKV + (rowbase + 32 * (kb + 1) + row) * 128 + 8 * ch); }
        f32x16 s = {};
#pragma unroll
        for (int ks = 0; ks < 8; ++ks) { const bf16x8 cf = *(const LAS bf16x8*)(ct + row_read_addr(lane, ks)); s = MFMA32(cf, qf[ks], s); }
        const unsigned mw = mrow[kb];
        float rm = -1e30f;
#pragma unroll
        for (int rg = 0; rg < 16; ++rg) { const int keyl = (rg & 3) + 8 * (rg >> 2) + 4 * hh; const bool sel = (mw >> keyl) & 1u; s[rg] = sel ? s[rg] : -1e30f; rm = fmaxf(rm, s[rg]); }
        rm = xhalf_max(rm);
        if (__any(rm > mrun + 8.0f)) {
            const float mn = (rm > mrun + 8.0f) ? rm : mrun; const float al = __builtin_amdgcn_exp2f(mrun - mn); mrun = mn; lrun *= al;
#pragma unroll
            for (int cb = 0; cb < 4; ++cb) o[cb] = o[cb] * al;
        }
        float ps = 0.f;
#pragma unroll
        for (int rg = 0; rg < 16; ++rg) { const float p = (s[rg] > -1e29f) ? __builtin_amdgcn_exp2f(s[rg] - mrun) : 0.f; s[rg] = p; ps += p; }
        lrun += ps;
        v4u pw[2];
#pragma unroll
        for (int sp = 0; sp < 2; ++sp) { pw[sp].x = cvtpk(s[8 * sp + 0], s[8 * sp + 1]); pw[sp].y = cvtpk(s[8 * sp + 2], s[8 * sp + 3]); pw[sp].z = cvtpk(s[8 * sp + 4], s[8 * sp + 5]); pw[sp].w = cvtpk(s[8 * sp + 6], s[8 * sp + 7]); }
#pragma unroll
        for (int cb = 0; cb < 4; ++cb)
#pragma unroll
            for (int sp = 0; sp < 2; ++sp) {
                const v4i16_t lo4 = lds_tr(ct + tr_read_addr_acc(lane, cb, 16 * sp)), hi4 = lds_tr(ct + tr_read_addr_acc(lane, cb, 16 * sp + 8));
                const bf16x8 af = {lo4[0], lo4[1], lo4[2], lo4[3], hi4[0], hi4[1], hi4[2], hi4[3]};
                o[cb] = MFMA32(af, __builtin_bit_cast(bf16x8, pw[sp]), o[cb]);
            }
        if (kb < qt) { const int row = tid >> 4, ch = tid & 15; *(LAS v4u*)(lds + DSA_CT + 8192 * ((kb + 1) & 1) + off_b(row, ch)) = nxt; }
        __syncthreads();
    }
    {
        const int lane2 = launder(F.lane), r = lane2 & 31, hh = lane2 >> 5;
        const float inv = 1.0f / xhalf_sum(lrun);
        LAS unsigned char* rowp = lds + DSA_QL + 8192 * w;
#pragma unroll
        for (int cb = 0; cb < 4; ++cb)
#pragma unroll
            for (int rg = 0; rg < 4; ++rg) { v2u ov; ov.x = cvtpk(o[cb][4 * rg] * inv, o[cb][4 * rg + 1] * inv); ov.y = cvtpk(o[cb][4 * rg + 2] * inv, o[cb][4 * rg + 3] * inv);
                *(LAS v2u*)(rowp + off_b((unsigned)r, 4 * cb + rg) + 8 * hh) = ov; }
    }
    __syncthreads();
    {
        const int lane2 = launder(F.lane), r = lane2 & 31, hh = lane2 >> 5;
        const int q = r; const LAS unsigned char* rowp = lds + DSA_QL + 8192 * (q >> 2); const unsigned n = (unsigned)((q & 3) * 8 + w);
        bf16x8 bo[8];
#pragma unroll
        for (int ks = 0; ks < 8; ++ks) bo[ks] = *(const LAS bf16x8*)(rowp + off_b(n, 2 * ks + hh));
#pragma unroll
        for (int db = 0; db < 2; ++db) {
            f32x16 acc = {};
#pragma unroll
            for (int ks = 0; ks < 8; ++ks) { const bf16x8 af = *(const GAS bf16x8*)(WUVT + ((size_t)(w * 64 + 32 * db + r)) * 128 + 16 * ks + 8 * hh); acc = MFMA32(af, bo[ks], acc); }
            bf16* dst = CAT + (rowbase + t0 + q) * 1024 + 512 + w * 64 + 32 * db + 4 * hh;
#pragma unroll
            for (int rg = 0; rg < 4; ++rg) { v2u ov; ov.x = cvtpk(acc[4 * rg], acc[4 * rg + 1]); ov.y = cvtpk(acc[4 * rg + 2], acc[4 * rg + 3]); *(GAS v2u*)(dst + 8 * rg) = ov; }
        }
    }
    __syncthreads();
}
__device__ __forceinline__ void dsa_fast_phase(Frame& F, const Args& A, const int l) {
    for (int c = blockIdx.x; c < 256; c += F.G) {
        const int b = c >> 5, qa = c & 31;
        dsa_item(F, A, l, b, qa);
        dsa_item(F, A, l, b, 63 - qa);
    }
}

#ifndef DSA_NAIVE
#define DSA_NAIVE 0
#endif
#ifndef RET_NAIVE
#define RET_NAIVE 1
#endif
#ifndef PH_MASK
#define PH_MASK 1023
#endif
template <int L> __device__ __forceinline__ void layer_phases(Frame& F, const Args& A, const XcdBarrier& bar, const int lo, const int hi) {
    constexpr int l = L, P0 = 1 + L * PH_PER_LAYER;
    unsigned char* ws = F.ws;
    bf16* ACT = (bf16*)(ws + WS_ACT);
    const float* xin = (l == 0) ? INP(IN_X) : F.out;
#define IN(k) (lo <= (k) && (k) < hi)
#define SEAM(k) do { if (IN(k) && IN((k) + 1)) xcd_barrier(bar); } while (0)
    if (IN(P0 + 0)) {
#if (PH_MASK >> 0) & 1
        pg8::Gemm g{ACT, (const bf16*)(ws + WS_WIN) + (size_t)l * NINP * DM, M, NINP, DM}; pg8::StaticOrder S; S.init(M, NINP, F.G, (int)blockIdx.x);
        pg8::EpiInProj E{(bf16*)(ws + WS_PROJ), (float*)(ws + WS_MISC), (const float*)(ws + WS_COS), (const float*)(ws + WS_SIN), M};
        pg8::gemm_phase<pg8::EpiInProj, pg8::StaticOrder, true, true>(F.lds + RING_OFF, g, S, E);
#endif
    }
    SEAM(P0 + 0);
    if (IN(P0 + 1)) {
#if (PH_MASK >> 1) & 1
        postproj_phase(F, A, l);
#endif
    }
    SEAM(P0 + 1);
    if (IN(P0 + 2)) {
#if (PH_MASK >> 2) & 1
#ifndef NO_RET
        ret_naive_phase(F, A, l);
#endif
#ifndef NO_DSA
#if DSA_NAIVE
        dsa_naive_phase(F, A, l);
#else
        dsa_fast_phase(F, A, l);
#endif
#endif
#endif
    }
    SEAM(P0 + 2);
    if (IN(P0 + 3)) {
#if (PH_MASK >> 3) & 1
        pg8::Gemm g{(const bf16*)(ws + WS_CAT), (const bf16*)(ws + WS_WOUT) + (size_t)l * DM * DM, M, DM, DM}; pg8::StaticOrder S; S.init(M, DM, F.G, (int)blockIdx.x);
        pg8::EpiF32 E{(float*)(ws + WS_TMPD), DM};
        pg8::gemm_phase<pg8::EpiF32, pg8::StaticOrder, true, true>(F.lds + RING_OFF, g, S, E);
#endif
    }
    SEAM(P0 + 3);
    if (IN(P0 + 4)) {
#if (PH_MASK >> 4) & 1
        norm_phase(F, (const float*)(ws + WS_TMPD), xin, F.out, INP(IN_POSTMIX) + l * DM, INP(IN_PREFFN) + l * DM, ACT);
#endif
    }
    SEAM(P0 + 4);
    if (IN(P0 + 5)) {
#if (PH_MASK >> 5) & 1
        pg8::Gemm g{ACT, (const bf16*)(ws + WS_WGU) + (size_t)l * NGU * DM, M, NGU, DM}; pg8::StaticOrder S; S.init(M, NGU, F.G, (int)blockIdx.x);
        pg8::EpiSwiGLU E{(bf16*)(ws + WS_HFF), DFF};
        pg8::gemm_phase<pg8::EpiSwiGLU, pg8::StaticOrder, true, true>(F.lds + RING_OFF, g, S, E);
#endif
    }
    SEAM(P0 + 5);
    if (IN(P0 + 6)) {
#if (PH_MASK >> 6) & 1
        pg8::Gemm g{(const bf16*)(ws + WS_HFF), (const bf16*)(ws + WS_WD) + (size_t)l * DM * DFF, M, DM, DFF}; pg8::StaticOrder S; S.init(M, DM, F.G, (int)blockIdx.x);
        pg8::EpiF32 E{(float*)(ws + WS_TMPF), DM};
        pg8::gemm_phase<pg8::EpiF32, pg8::StaticOrder, true, true>(F.lds + RING_OFF, g, S, E);
#endif
    }
    SEAM(P0 + 6);
    if (IN(P0 + 7)) {
#if (PH_MASK >> 7) & 1
        norm_phase(F, (const float*)(ws + WS_TMPF), F.out, F.out, INP(IN_POSTFFN) + l * DM, nullptr, (bf16*)(ws + WS_XB));
#endif
    }
    SEAM(P0 + 7);
    if (IN(P0 + 8)) {
#if (PH_MASK >> 8) & 1
        { int Kp = PLE; asm volatile("" : "+s"(Kp));
          pg8::Gemm g{(const bf16*)(ws + WS_PB) + (size_t)l * M * PLE, (const bf16*)(ws + WS_WPU) + (size_t)l * DM * PLE, M, DM, Kp}; pg8::StaticOrder S; S.init(M, DM, F.G, (int)blockIdx.x);
          pg8::EpiBf16Plain E{(bf16*)(ws + WS_EB), DM};
          pg8::gemm_phase<pg8::EpiBf16Plain, pg8::StaticOrder, true, true>(F.lds + RING_OFF, g, S, E); }
        VM_WAIT(); __threadfence(); __syncthreads();
        { pg8::Gemm g{(const bf16*)(ws + WS_XB), (const bf16*)(ws + WS_WPG) + (size_t)l * DM * DM, M, DM, DM}; pg8::StaticOrder S; S.init(M, DM, F.G, (int)blockIdx.x);
          pg8::EpiGateMul E{(const bf16*)(ws + WS_EB), (float*)(ws + WS_TMPG), DM};
          pg8::gemm_phase<pg8::EpiGateMul, pg8::StaticOrder, true, true>(F.lds + RING_OFF, g, S, E); }
#endif
    }
    SEAM(P0 + 8);
    if (IN(P0 + 9)) {
#if (PH_MASK >> 9) & 1
        norm_phase(F, (const float*)(ws + WS_TMPG), F.out, F.out, INP(IN_PLEG) + l * DM, (l + 1 < DEPTH) ? INP(IN_PREMIX) + (l + 1) * DM : nullptr, (l + 1 < DEPTH) ? ACT : nullptr);
#endif
    }
    SEAM(P0 + 9);
#undef IN
#undef SEAM
}

__global__ void __launch_bounds__(NWAVES * 64, 2) fwd_mega(Args A) {
    extern __shared__ __attribute__((aligned(16))) unsigned char lds[];
    Frame F;
    F.lds = (LAS unsigned char*)lds;
    F.MISC = (volatile LAS unsigned*)(F.lds + MISC_OFF);
    F.tid = threadIdx.x; F.lane = F.tid & 63; F.wave = __builtin_amdgcn_readfirstlane(F.tid >> 6);
    F.G = gridDim.x;
    F.ws = A.ws; F.out = A.out; F.ctl = (gu32*)(A.ws + WS_CTL);
    for (int u = F.tid; u < (LDS_BYTES - LDSCTL_OFF) / 4; u += NWAVES * 64) ((LAS unsigned*)(F.lds + LDSCTL_OFF))[u] = 0u;
    __syncthreads();
    const int lo = A.ph_lo, hi = A.ph_hi;
    XcdBarrier bar; bar.bar = (unsigned*)(F.ctl + CW_BAR); bar.x = 0; bar.st = nullptr;
    if (hi - lo > 1) bar = xcd_barrier_post((unsigned*)(F.ctl + CW_BAR), F.MISC + 8);
#define IN(k) (lo <= (k) && (k) < hi)
#define SEAM(k) do { if (IN(k) && IN((k) + 1)) xcd_barrier(bar); } while (0)
    if (IN(0)) p0_prologue(F, A);
    SEAM(0);
    layer_phases<0>(F, A, bar, lo, hi);
    layer_phases<1>(F, A, bar, lo, hi);
}

extern "C" void kernel_launch(void* const* d_in, const int* in_sizes, int n_in, void* d_out, int out_size, void* d_ws, size_t ws_size, hipStream_t stream) {
    static int grid = 0;
    if (grid == 0) {
        if (n_in != 22 || out_size != M * DM || ws_size < WS_END) { fprintf(stderr, "kernel_launch: unexpected shapes: n_in %d out %d ws %zu\n", n_in, out_size, ws_size); grid = -1; return; }
        int dev = 0, cus = 0;
        if (hipGetDevice(&dev) != hipSuccess || hipDeviceGetAttribute(&cus, hipDeviceAttributeMultiprocessorCount, dev) != hipSuccess) { grid = -1; return; }
        if (hipFuncSetAttribute((const void*)fwd_mega, hipFuncAttributeMaxDynamicSharedMemorySize, LDS_BYTES) != hipSuccess) { fprintf(stderr, "kernel_launch: hipFuncSetAttribute failed\n"); grid = -1; return; }
        (void)hipGetLastError();
        grid = cus;
    }
    if (grid < 0) return;
    if (hipMemsetAsync((char*)d_ws + WS_CTL, 0, CTL_ZERO_BYTES, stream) != hipSuccess) return;
    Args a{};
    for (int i = 0; i < 22; ++i) a.in[i] = d_in[i];
    a.out = (float*)d_out; a.ws = (unsigned char*)d_ws;
#if MK_PER_PHASE
    for (int ph = 0; ph < NPH; ++ph) { a.ph_lo = ph; a.ph_hi = ph + 1; hipLaunchKernelGGL(fwd_mega, dim3(grid), dim3(NWAVES * 64), LDS_BYTES, stream, a); }
#else
    a.ph_lo = 0; a.ph_hi = NPH;
    hipLaunchKernelGGL(fwd_mega, dim3(grid), dim3(NWAVES * 64), LDS_BYTES, stream, a);
#endif
}
```

```cpp
#include <hip/hip_runtime.h>
#include <cstdio>
#include <cstdint>
#include <cmath>

#ifndef MK_PER_PHASE
#define MK_PER_PHASE 0
#endif

namespace pg8 {
#define PG8_LAS __attribute__((address_space(3)))
typedef unsigned short bf16_t;
typedef short bf16x8 __attribute__((ext_vector_type(8)));
typedef float f32x4 __attribute__((ext_vector_type(4)));
typedef unsigned u32x4 __attribute__((ext_vector_type(4)));
typedef unsigned u32x2 __attribute__((ext_vector_type(2)));
constexpr int BM = 256, BK = 64, HALF = 128, HTB = HALF * BK * 2, STAGE_BYTES = 8 * HTB, NXCD = 8, WGM = 8;

__host__ __device__ __forceinline__ int lds_byte(int r, int c) { const int st = (r >> 4) * 2 + (c >> 5), rr = r & 15, cc = c & 31, ob = rr * 64 + cc * 2; return st * 1024 + (ob ^ (((ob >> 9) & 1) << 5)); }
__host__ __device__ __forceinline__ void stage_rc(int b, int& R, int& C) { const int st = b / 1024, sb = b % 1024, swz = sb ^ (((sb >> 9) & 1) << 5); R = (st >> 1) * 16 + swz / 64; C = (st & 1) * 32 + (swz % 64) / 2; }
__host__ __device__ __forceinline__ int perm32(int rho) { const int n = rho >> 4, i = rho & 15; return 8 * (i >> 2) + 4 * n + (i & 3); }

struct Unit { int pm, pn; };
struct Gemm { const bf16_t* A; const bf16_t* Bt; int M, N, K; };

struct StaticOrder {
    int nM, nN, nwg, G, c;
    __host__ __device__ void init(int M, int N, int G_, int c_) { nM = M / BM; nN = N / BM; nwg = nM * nN; G = G_; c = c_; }
    __host__ __device__ bool next(int i, Unit& u) const {
        const long L = (long)i * G + c; if (L >= nwg) return false;
        int wgid = (int)L; { const int q = nwg / NXCD, r = nwg % NXCD, xcd = wgid % NXCD, off = wgid / NXCD; wgid = (xcd < r ? xcd * (q + 1) : r * (q + 1) + (xcd - r) * q) + off; }
        const int nig = WGM * nN, gid = wgid / nig, fm = gid * WGM, gsz = (nM - fm) < WGM ? (nM - fm) : WGM;
        u.pm = fm + ((wgid % nig) % gsz); u.pn = (wgid % nig) / gsz; return true;
    }
    __device__ __forceinline__ void a_ready(const Unit&) const {}
    __device__ __forceinline__ void done(const Unit&) const {}
};

__device__ __forceinline__ unsigned cvt_pk_bf16(float lo, float hi) { unsigned r; asm volatile("v_cvt_pk_bf16_f32 %0, %1, %2" : "=v"(r) : "v"(lo), "v"(hi)); return r; }
__device__ __forceinline__ float silu_f(float x) { return x / (1.f + __expf(-x)); }
__device__ __forceinline__ float sigmoid_f(float x) { return 1.f / (1.f + __expf(-x)); }
__device__ __forceinline__ float bf_lo(unsigned w) { return __uint_as_float(w << 16); }
__device__ __forceinline__ float bf_hi(unsigned w) { return __uint_as_float(w & 0xffff0000u); }


struct EpiInProj {
    static constexpr bool PERM = true, AFTER_DRAIN = false;
    bf16_t* proj; float* misc; const float* cosT; const float* sinT; int Mrows;
    __device__ __forceinline__ void operator()(const f32x4 (&acc)[2][2][4][2], const Unit& u, int wr, int wc, int fr, int fq) const {
        const int row0 = u.pm * BM + wr * 64 + fr;
        if (u.pn == 12) {
#pragma unroll
            for (int ai = 0; ai < 2; ++ai)
#pragma unroll
                for (int m = 0; m < 4; ++m) { float* rowp = misc + (size_t)(row0 + ai * HALF + m * 16) * 256 + wc * 32 + 8 * fq;
#pragma unroll
                    for (int bj = 0; bj < 2; ++bj) { *(f32x4*)(rowp + bj * HALF) = acc[ai][bj][m][0]; *(f32x4*)(rowp + bj * HALF + 4) = acc[ai][bj][m][1]; } }
            return;
        }
        const int t = u.pn >> 1, colt = (u.pn & 1) * 256 + wc * 32 + 8 * fq;
        bf16_t* base = proj + (size_t)t * Mrows * 512;
        const int u8 = ((wc & 1) * 4 + fq);
#pragma unroll
        for (int ai = 0; ai < 2; ++ai)
#pragma unroll
            for (int m = 0; m < 4; ++m) { const int row = row0 + ai * HALF + m * 16; bf16_t* rowp = base + (size_t)row * 512 + colt;
                f32x4 cs = {1.f, 1.f, 1.f, 1.f}, sn = {0.f, 0.f, 0.f, 0.f};
                if (t <= 1) { cs = *(const f32x4*)(cosT + (size_t)row * 32 + 4 * u8); sn = *(const f32x4*)(sinT + (size_t)row * 32 + 4 * u8); }
#pragma unroll
                for (int bj = 0; bj < 2; ++bj) { f32x4 v0 = acc[ai][bj][m][0], v1 = acc[ai][bj][m][1];
                    if (t <= 1) { const f32x4 o0 = v0 * cs - v1 * sn, o1 = v0 * sn + v1 * cs; v0 = o0; v1 = o1; if (t == 1) { v0 = v0 * 0.125f; v1 = v1 * 0.125f; } }
                    else if (t == 3) {
#pragma unroll
                        for (int i = 0; i < 4; ++i) { v0[i] = silu_f(v0[i]); v1[i] = silu_f(v1[i]); } }
                    u32x4 w; w.x = cvt_pk_bf16(v0[0], v0[1]); w.y = cvt_pk_bf16(v0[2], v0[3]); w.z = cvt_pk_bf16(v1[0], v1[1]); w.w = cvt_pk_bf16(v1[2], v1[3]);
                    *(u32x4*)(rowp + bj * HALF) = w; } }
    }
};
struct EpiF32 {
    static constexpr bool PERM = false, AFTER_DRAIN = false;
    float* C; int ldc;
    __device__ __forceinline__ void operator()(const f32x4 (&acc)[2][2][4][2], const Unit& u, int wr, int wc, int fr, int fq) const {
        const int row0 = u.pm * BM + wr * 64 + fr, col0 = u.pn * BM + wc * 32 + 4 * fq;
#pragma unroll
        for (int ai = 0; ai < 2; ++ai)
#pragma unroll
            for (int m = 0; m < 4; ++m) { float* rowp = C + (size_t)(row0 + ai * HALF + m * 16) * ldc + col0;
#pragma unroll
                for (int bj = 0; bj < 2; ++bj)
#pragma unroll
                    for (int n = 0; n < 2; ++n) *(f32x4*)(rowp + bj * HALF + n * 16) = acc[ai][bj][m][n]; }
    }
};
struct EpiSwiGLU {
    static constexpr bool PERM = true, AFTER_DRAIN = false;
    bf16_t* O; int ldo;
    __device__ __forceinline__ void operator()(const f32x4 (&acc)[2][2][4][2], const Unit& u, int wr, int wc, int fr, int fq) const {
        const int row0 = u.pm * BM + wr * 64 + fr, hcol0 = u.pn * 128 + wc * 16 + 4 * fq;
#pragma unroll
        for (int ai = 0; ai < 2; ++ai)
#pragma unroll
            for (int m = 0; m < 4; ++m) { bf16_t* rowp = O + (size_t)(row0 + ai * HALF + m * 16) * ldo + hcol0;
#pragma unroll
                for (int bj = 0; bj < 2; ++bj) { const f32x4 g = acc[ai][bj][m][0], up = acc[ai][bj][m][1]; f32x4 o;
#pragma unroll
                    for (int i = 0; i < 4; ++i) o[i] = silu_f(g[i]) * up[i];
                    u32x2 w; w.x = cvt_pk_bf16(o[0], o[1]); w.y = cvt_pk_bf16(o[2], o[3]);
                    *(u32x2*)(rowp + bj * 64) = w; } }
    }
};
struct EpiBf16Plain {
    static constexpr bool PERM = true, AFTER_DRAIN = false;
    bf16_t* O; int ldo;
    __device__ __forceinline__ void operator()(const f32x4 (&acc)[2][2][4][2], const Unit& u, int wr, int wc, int fr, int fq) const {
        const int row0 = u.pm * BM + wr * 64 + fr, col0 = u.pn * BM + wc * 32 + 8 * fq;
#pragma unroll
        for (int ai = 0; ai < 2; ++ai)
#pragma unroll
            for (int m = 0; m < 4; ++m) { bf16_t* rowp = O + (size_t)(row0 + ai * HALF + m * 16) * ldo + col0;
#pragma unroll
                for (int bj = 0; bj < 2; ++bj) { const f32x4 v0 = acc[ai][bj][m][0], v1 = acc[ai][bj][m][1];
                    u32x4 w; w.x = cvt_pk_bf16(v0[0], v0[1]); w.y = cvt_pk_bf16(v0[2], v0[3]); w.z = cvt_pk_bf16(v1[0], v1[1]); w.w = cvt_pk_bf16(v1[2], v1[3]);
                    *(u32x4*)(rowp + bj * HALF) = w; } }
    }
};
struct EpiGateMul {
    static constexpr bool PERM = true, AFTER_DRAIN = false;
    const bf16_t* E; float* C; int ldc;
    __device__ __forceinline__ void operator()(const f32x4 (&acc)[2][2][4][2], const Unit& u, int wr, int wc, int fr, int fq) const {
        const int row0 = u.pm * BM + wr * 64 + fr, col0 = u.pn * BM + wc * 32 + 8 * fq;
#pragma unroll
        for (int ai = 0; ai < 2; ++ai)
#pragma unroll
            for (int m = 0; m < 4; ++m) { const size_t off = (size_t)(row0 + ai * HALF + m * 16) * ldc + col0;
#pragma unroll
                for (int bj = 0; bj < 2; ++bj) { const u32x4 e = *(const u32x4*)(E + off + bj * HALF); const f32x4 v0 = acc[ai][bj][m][0], v1 = acc[ai][bj][m][1]; f32x4 o0, o1;
                    o0[0] = sigmoid_f(v0[0]) * bf_lo(e.x); o0[1] = sigmoid_f(v0[1]) * bf_hi(e.x); o0[2] = sigmoid_f(v0[2]) * bf_lo(e.y); o0[3] = sigmoid_f(v0[3]) * bf_hi(e.y);
                    o1[0] = sigmoid_f(v1[0]) * bf_lo(e.z); o1[1] = sigmoid_f(v1[1]) * bf_hi(e.z); o1[2] = sigmoid_f(v1[2]) * bf_lo(e.w); o1[3] = sigmoid_f(v1[3]) * bf_hi(e.w);
                    *(f32x4*)(C + off + bj * HALF) = o0; *(f32x4*)(C + off + bj * HALF + 4) = o1; }
                asm volatile("" ::: "memory"); }
    }
};

template <class Epi, class Sched, bool ALIGN_EPI = false, bool SP2 = false>
__device__ __forceinline__ void gemm_phase(PG8_LAS unsigned char* lds, const Gemm g, const Sched& S, const Epi& E) {
    const int tid = threadIdx.x, wid = __builtin_amdgcn_readfirstlane(tid >> 6), lane = tid & 63, wr = wid >> 2, wc = wid & 3, fr = lane & 15, fq = lane >> 4;
    const int K = g.K, nt = K / BK;
    unsigned voffA[2], voffB[2];
#pragma unroll
    for (int i = 0; i < 2; ++i) { int R, C; stage_rc(tid * 16 + i * 8192, R, C); const int Rb = Epi::PERM ? ((R & ~31) + perm32(R & 31)) : R;
        voffA[i] = (unsigned)(R * K + C) * 2u; voffB[i] = (unsigned)(Rb * K + C) * 2u; }
    const size_t kstep = (size_t)(BK * 2);
    const size_t hstep = (size_t)HALF * K * 2;
    const size_t tstep = 2 * hstep;
    const unsigned ldsw = (unsigned)wid * 1024u;
    const int aoff = lds_byte(wr * 64 + fr, fq * 8), boff = lds_byte(wc * 32 + fr, fq * 8);
#define PG8_SA(b, h) (((b) * 2 + (h)) * HTB)
#define PG8_SB(b, h) ((4 + (b) * 2 + (h)) * HTB)
#define PG8_STAGE(bufoff, gbase, voff) do { _Pragma("unroll") for (int _i = 0; _i < 2; ++_i) \
        __builtin_amdgcn_global_load_lds((const unsigned*)((const char*)(gbase) + (voff)[_i]), (PG8_LAS unsigned*)(lds + (bufoff) + ldsw + _i * 8192), 16, 0, 0); } while (0)
#define PG8_LDA(dst, b, h) do { _Pragma("unroll") for (int m = 0; m < 4; ++m) _Pragma("unroll") for (int k = 0; k < 2; ++k) dst[m][k] = *(const PG8_LAS bf16x8*)(lds + PG8_SA(b, h) + aoff + m * 2048 + k * 1024); } while (0)
#define PG8_LDB(dst, b, h) do { _Pragma("unroll") for (int n = 0; n < 2; ++n) _Pragma("unroll") for (int k = 0; k < 2; ++k) dst[n][k] = *(const PG8_LAS bf16x8*)(lds + PG8_SB(b, h) + boff + n * 2048 + k * 1024); } while (0)
#define PG8_MMA(ai, bj, At, Bt) do { __builtin_amdgcn_s_setprio(1); _Pragma("unroll") for (int m = 0; m < 4; ++m) _Pragma("unroll") for (int n = 0; n < 2; ++n) _Pragma("unroll") for (int k = 0; k < 2; ++k) \
        acc[ai][bj][m][n] = __builtin_amdgcn_mfma_f32_16x16x32_bf16(Bt[n][k], At[m][k], acc[ai][bj][m][n], 0, 0, 0); __builtin_amdgcn_s_setprio(0); } while (0)
#define PG8_WAIT_V(n) asm volatile("s_waitcnt vmcnt(" #n ")" ::: "memory")
#define PG8_WAIT_L(n) asm volatile("s_waitcnt lgkmcnt(" #n ")" ::: "memory")
#define PG8_BAR __builtin_amdgcn_s_barrier()
#define PG8_SCHED __builtin_amdgcn_sched_barrier(0)
    Unit cur, nxt; int ui = 0;
    if (!S.next(0, cur)) return;
    f32x4 acc[2][2][4][2];
#pragma unroll
    for (int a = 0; a < 2; ++a)
#pragma unroll
        for (int b = 0; b < 2; ++b)
#pragma unroll
            for (int m = 0; m < 4; ++m)
#pragma unroll
                for (int n = 0; n < 2; ++n) acc[a][b][m][n] = (f32x4){0.f, 0.f, 0.f, 0.f};
    bf16x8 At[4][2], B0[2][2], B1[2][2];
    const char* cA = (const char*)g.A + (size_t)cur.pm * tstep; const char* cB = (const char*)g.Bt + (size_t)cur.pn * tstep;
    S.a_ready(cur);
    if constexpr (SP2) {
        PG8_STAGE(PG8_SB(0, 0), cB, voffB); PG8_STAGE(PG8_SB(0, 1), cB + hstep, voffB); PG8_STAGE(PG8_SA(0, 0), cA, voffA); PG8_STAGE(PG8_SA(0, 1), cA + hstep, voffA);
        if (wr == 1) PG8_BAR;
        PG8_WAIT_V(2); PG8_BAR;
        PG8_STAGE(PG8_SB(1, 0), cB + kstep, voffB); PG8_STAGE(PG8_SA(1, 0), cA + kstep, voffA); PG8_STAGE(PG8_SB(1, 1), cB + hstep + kstep, voffB);
        PG8_WAIT_V(6); PG8_BAR;
    } else {
        PG8_STAGE(PG8_SB(0, 0), cB, voffB); PG8_STAGE(PG8_SA(0, 0), cA, voffA); PG8_STAGE(PG8_SB(0, 1), cB + hstep, voffB); PG8_STAGE(PG8_SA(0, 1), cA + hstep, voffA);
        if (wr == 1) PG8_BAR;
        PG8_WAIT_V(4); PG8_BAR;
        PG8_STAGE(PG8_SB(1, 0), cB + kstep, voffB); PG8_STAGE(PG8_SA(1, 0), cA + kstep, voffA); PG8_STAGE(PG8_SB(1, 1), cB + hstep + kstep, voffB);
        PG8_WAIT_V(6); PG8_BAR;
    }
    for (;;) {
        const bool has_next = S.next(ui + 1, nxt);
        const char* nA = has_next ? (const char*)g.A + (size_t)nxt.pm * tstep : cA; const char* nB = has_next ? (const char*)g.Bt + (size_t)nxt.pn * tstep : cB;
        for (int t = 0; t < nt; t += 2) {
            const bool last = (t == nt - 2);
            const char* a1 = cA + (size_t)(t + 1) * kstep;
            const char* a2 = last ? nA : cA + (size_t)(t + 2) * kstep; const char* b2 = last ? nB : cB + (size_t)(t + 2) * kstep;
            const char* a3 = a2 + kstep; const char* b3 = b2 + kstep;
            if (last && has_next) S.a_ready(nxt);
            if constexpr (SP2) {
            PG8_LDB(B0, 0, 0); PG8_LDB(B1, 0, 1); PG8_SCHED; PG8_LDA(At, 0, 0); PG8_STAGE(PG8_SA(1, 1), a1 + hstep, voffA);
            PG8_WAIT_V(8); PG8_WAIT_L(0); PG8_BAR; PG8_MMA(0, 0, At, B0); PG8_MMA(0, 1, At, B1); PG8_BAR; PG8_SCHED;
            PG8_LDA(At, 0, 1); PG8_STAGE(PG8_SB(0, 0), b2, voffB); PG8_STAGE(PG8_SB(0, 1), b2 + hstep, voffB); PG8_STAGE(PG8_SA(0, 0), a2, voffA);
            PG8_WAIT_V(8); PG8_WAIT_L(0); PG8_BAR; PG8_MMA(1, 0, At, B0); PG8_MMA(1, 1, At, B1); PG8_BAR; PG8_SCHED;
            PG8_LDB(B0, 1, 0); PG8_LDB(B1, 1, 1); PG8_SCHED; PG8_LDA(At, 1, 0); PG8_STAGE(PG8_SA(0, 1), a2 + hstep, voffA);
            PG8_WAIT_V(8); PG8_WAIT_L(0); PG8_BAR; PG8_MMA(0, 0, At, B0); PG8_MMA(0, 1, At, B1); PG8_BAR; PG8_SCHED;
            PG8_LDA(At, 1, 1); PG8_STAGE(PG8_SB(1, 0), b3, voffB); PG8_STAGE(PG8_SB(1, 1), b3 + hstep, voffB); PG8_STAGE(PG8_SA(1, 0), a3, voffA);
            PG8_WAIT_V(8); PG8_WAIT_L(0); PG8_BAR; PG8_MMA(1, 0, At, B0); PG8_MMA(1, 1, At, B1); PG8_BAR; PG8_SCHED;
            } else {
            PG8_LDB(B0, 0, 0); PG8_SCHED; PG8_LDA(At, 0, 0); PG8_STAGE(PG8_SA(1, 1), a1 + hstep, voffA);
            PG8_WAIT_L(8); PG8_BAR; PG8_WAIT_L(0); PG8_MMA(0, 0, At, B0); PG8_BAR; PG8_SCHED;
            PG8_LDB(B1, 0, 1); PG8_STAGE(PG8_SB(0, 0), b2, voffB);
            PG8_BAR; PG8_WAIT_L(0); PG8_MMA(0, 1, At, B1); PG8_BAR;
            PG8_LDA(At, 0, 1); PG8_STAGE(PG8_SA(0, 0), a2, voffA);
            PG8_BAR; PG8_WAIT_L(0); PG8_MMA(1, 0, At, B0); PG8_BAR; PG8_SCHED;
            PG8_STAGE(PG8_SB(0, 1), b2 + hstep, voffB);
            PG8_WAIT_V(6); PG8_BAR; PG8_MMA(1, 1, At, B1); PG8_BAR;
            PG8_LDB(B0, 1, 0); PG8_SCHED; PG8_LDA(At, 1, 0); PG8_STAGE(PG8_SA(0, 1), a2 + hstep, voffA);
            PG8_WAIT_L(8); PG8_BAR; PG8_WAIT_L(0); PG8_MMA(0, 0, At, B0); PG8_BAR; PG8_SCHED;
            PG8_LDB(B1, 1, 1); PG8_STAGE(PG8_SB(1, 0), b3, voffB);
            PG8_BAR; PG8_WAIT_L(0); PG8_MMA(0, 1, At, B1); PG8_BAR;
            PG8_LDA(At, 1, 1); PG8_STAGE(PG8_SA(1, 0), a3, voffA);
            PG8_BAR; PG8_WAIT_L(0); PG8_MMA(1, 0, At, B0); PG8_BAR; PG8_SCHED;
            PG8_STAGE(PG8_SB(1, 1), b3 + hstep, voffB);
            PG8_WAIT_V(6); PG8_BAR; PG8_MMA(1, 1, At, B1); PG8_BAR;
            }
        }
        if constexpr (ALIGN_EPI) { if (wr == 0) PG8_BAR; }
        if constexpr (!Epi::AFTER_DRAIN) { E(acc, cur, wr, wc, fr, fq); S.done(cur); }
        if (!has_next) break;
#pragma unroll
        for (int a = 0; a < 2; ++a)
#pragma unroll
            for (int b = 0; b < 2; ++b)
#pragma unroll
                for (int m = 0; m < 4; ++m)
#pragma unroll
                    for (int n = 0; n < 2; ++n) acc[a][b][m][n] = (f32x4){0.f, 0.f, 0.f, 0.f};
        cur = nxt; cA = nA; cB = nB; ++ui;
        if constexpr (ALIGN_EPI) { if (wr == 1) PG8_BAR; }
    }
    PG8_WAIT_V(0);
    if constexpr (!ALIGN_EPI) { if (wr == 0) PG8_BAR; }
    PG8_BAR;
    if constexpr (Epi::AFTER_DRAIN) { E.fused(acc, cur, wr, wc, fr, fq, lds, wid, lane); S.done(cur); }
#undef PG8_SA
#undef PG8_SB
#undef PG8_STAGE
#undef PG8_LDA
#undef PG8_LDB
#undef PG8_MMA
#undef PG8_WAIT_V
#undef PG8_WAIT_L
#undef PG8_BAR
#undef PG8_SCHED
}
}

constexpr int NWAVES = 8, NTHREADS = 512;
constexpr int BATCH = 8, SEQ = 2048, DM = 1024, M = BATCH * SEQ, DEPTH = 2;
constexpr int NIN = 3272, NINP = 3328, DFF = 2816, PLE = 256, NGU = 2 * DFF;
constexpr float EPS = 1e-6f;
constexpr int PH_PER_LAYER = 10, NPH = 1 + DEPTH * PH_PER_LAYER;

constexpr size_t MiB = 1u << 20;
constexpr size_t WS_CTL = 0, CTL_ZERO_BYTES = 1 * MiB;
constexpr size_t WS_WIN = 1 * MiB, WS_WOUT = 14 * MiB, WS_WGU = 18 * MiB, WS_WD = 40 * MiB, WS_WPU = 51 * MiB, WS_WPG = 52 * MiB, WS_WUK = 56 * MiB, WS_WUV = 56 * MiB + 512 * 1024;
constexpr size_t WS_PB = 57 * MiB, WS_COS = 73 * MiB, WS_SIN = 75 * MiB;
constexpr size_t WS_PROJ = 80 * MiB;
constexpr size_t WS_HFF = 80 * MiB, WS_TMPD = 80 * MiB, WS_XB = 80 * MiB, WS_TMPG = 112 * MiB;
constexpr size_t WS_ACT = 176 * MiB;
constexpr size_t WS_CKV = 176 * MiB, WS_KI = 180 * MiB, WS_WI = 182 * MiB, WS_RST = 184 * MiB, WS_KV = 192 * MiB;
constexpr size_t WS_CAT = 208 * MiB, WS_EB = 208 * MiB;
constexpr size_t WS_TMPF = 176 * MiB;
constexpr size_t WS_MISC = 240 * MiB, WS_END = 256 * MiB;
static_assert(WS_WIN + (size_t)DEPTH * NINP * DM * 2 <= WS_WOUT && WS_WGU + (size_t)DEPTH * NGU * DM * 2 <= WS_WD && WS_WD + (size_t)DEPTH * DM * DFF * 2 <= WS_WPU, "ws map");
static_assert(WS_PROJ + (size_t)6 * M * 512 * 2 <= WS_ACT && WS_HFF + (size_t)M * DFF * 2 <= WS_ACT && WS_MISC + (size_t)M * 256 * 4 <= WS_END, "ws map");
constexpr int CW_BAR = 4096;

constexpr int RING_OFF = 0, RING_BYTES = 131072;
constexpr int LDSCTL_OFF = RING_BYTES, MISC_OFF = LDSCTL_OFF + 320;
constexpr int LDS_BYTES = 147456;

#define GAS __attribute__((address_space(1)))
#define LAS __attribute__((address_space(3)))
typedef unsigned short bf16;
typedef unsigned v4u __attribute__((ext_vector_type(4)));
typedef unsigned v2u __attribute__((ext_vector_type(2)));
typedef float f32x4 __attribute__((ext_vector_type(4)));
typedef short bf16x8 __attribute__((ext_vector_type(8)));
typedef GAS unsigned gu32;
#define RLX_AGENT __ATOMIC_RELAXED, __HIP_MEMORY_SCOPE_AGENT
#define LDS_WAIT() asm volatile("s_waitcnt lgkmcnt(0)" ::: "memory")
#define VM_WAIT() asm volatile("s_waitcnt vmcnt(0)" ::: "memory")
__device__ __forceinline__ unsigned f2bf(float f) { unsigned u = __builtin_bit_cast(unsigned, f); return (u + 0x7fffu + ((u >> 16) & 1u)) >> 16; }
__device__ __forceinline__ unsigned pk2(float lo, float hi) { return f2bf(lo) | (f2bf(hi) << 16); }
using pg8::bf_lo; using pg8::bf_hi;

#define XB_TMO      128
#define XB_XCNT(j)  (256  + 64 * (j))
#define XB_XSUB(j)  (1280 + 64 * (j))
#define XB_XGEN(j)  (2304 + 64 * (j))
#define XB_TOP      3328
#define XB_TOPGEN   3392
#define XCD_BAR_WORDS 3456
#define XB_SPIN_CAP (1u << 18)

__device__ __forceinline__ unsigned xb_ld(unsigned* p)              { return __hip_atomic_load(p, __ATOMIC_RELAXED, __HIP_MEMORY_SCOPE_AGENT); }
__device__ __forceinline__ unsigned xb_add(unsigned* p, unsigned v) { return __hip_atomic_fetch_add(p, v, __ATOMIC_RELAXED, __HIP_MEMORY_SCOPE_AGENT); }
__device__ __forceinline__ unsigned xb_xcc_id() { return (unsigned)__builtin_amdgcn_s_getreg((3 << 11) | 20) & 0xFu; }
#define XB_SPIN(cond, bar) do { unsigned _sp = 0; while (cond) { __builtin_amdgcn_s_sleep(1); \
    if ((++_sp & 255u) == 0u) { if (xb_ld(&(bar)[XB_TMO])) break; if (_sp > XB_SPIN_CAP) { atomicAdd(&(bar)[XB_TMO], 1u); break; } } } } while (0)

struct XcdBarrier {
    unsigned* bar; unsigned x;
    volatile LAS unsigned* st;
};

__device__ __forceinline__ XcdBarrier xcd_barrier_post(unsigned* bar, volatile LAS unsigned* st) {
    XcdBarrier b; b.bar = bar; b.x = xb_xcc_id(); b.st = st;
    if (threadIdx.x == 0) (void)xb_add(&bar[XB_XCNT(b.x)], 1u);
    return b;
}
__device__ __forceinline__ void xcd_barrier_complete(unsigned* bar, unsigned x, unsigned& nloc, unsigned& nx) {
    const unsigned G = gridDim.x * gridDim.y * gridDim.z;
    unsigned sum, cnt, mine, sp = 0u;
    for (;;) {
        sum = 0u; cnt = 0u; mine = 0u;
#pragma unroll
        for (unsigned j = 0; j < 16; ++j) { const unsigned c = xb_ld(&bar[XB_XCNT(j)]); sum += c; cnt += (c > 0u) ? 1u : 0u; mine = (j == x) ? c : mine; }
        if (sum == G) break;
        __builtin_amdgcn_s_sleep(1);
        if ((++sp & 255u) == 0u) { if (xb_ld(&bar[XB_TMO])) break; if (sp > XB_SPIN_CAP) { atomicAdd(&bar[XB_TMO], 1u); break; } }
    }
    nloc = mine > 0u ? mine : 1u; nx = cnt > 0u ? cnt : 1u;
}

__device__ __forceinline__ void xcd_barrier(const XcdBarrier& b) {
    asm volatile("s_waitcnt vmcnt(0)" ::: "memory");
    __syncthreads();
    if (threadIdx.x == 0) {
        unsigned* bar = b.bar;
        __builtin_amdgcn_s_waitcnt(0);
        unsigned nloc = b.st[0], nx = b.st[1];
        if (nloc == 0u) { xcd_barrier_complete(bar, b.x, nloc, nx); b.st[0] = nloc; b.st[1] = nx; }
        const unsigned old = xb_add(&bar[XB_XSUB(b.x)], 1u);
        const unsigned gen = old / nloc;
        if (old + 1u == (gen + 1u) * nloc) {
            __builtin_amdgcn_fence(__ATOMIC_RELEASE, "agent");
            asm volatile("s_waitcnt vmcnt(0)" ::: "memory");
            const unsigned og = xb_add(&bar[XB_TOP], 1u);
            const unsigned tg = og / nx;
            if (og + 1u == (tg + 1u) * nx) xb_add(&bar[XB_TOPGEN], 1u);
            else XB_SPIN(xb_ld(&bar[XB_TOPGEN]) == tg, bar);
            __builtin_amdgcn_fence(__ATOMIC_ACQUIRE, "agent");
            xb_add(&bar[XB_XGEN(b.x)], 1u);
            asm volatile("s_waitcnt vmcnt(0)" ::: "memory");
        } else {
            XB_SPIN(xb_ld(&bar[XB_XGEN(b.x)]) == gen, bar);
            __builtin_amdgcn_fence(__ATOMIC_ACQUIRE, "agent");
            asm volatile("s_waitcnt vmcnt(0)" ::: "memory");
        }
    }
    __syncthreads();
}

struct Frame {
    LAS unsigned char* lds;
    volatile LAS unsigned* MISC;
    gu32* ctl;
    int tid, lane, wave, G;
    float* out; unsigned char* ws;
};
struct Args { const void* in[22]; float* out; unsigned char* ws; int ph_lo, ph_hi; };
#define INP(k) ((const float*)A.in[k])
#define IN_X 0
#define IN_P 1
#define IN_POS 2
#define IN_PREMIX 3
#define IN_WIN 4
#define IN_RETG 5
#define IN_RETB 6
#define IN_KVG 7
#define IN_IKG 8
#define IN_IKB 9
#define IN_WUK 10
#define IN_WUV 11
#define IN_WOUT 12
#define IN_POSTMIX 13
#define IN_PREFFN 14
#define IN_WGATE 15
#define IN_WUP 16
#define IN_WDOWN 17
#define IN_POSTFFN 18
#define IN_WPU 19
#define IN_WPG 20
#define IN_PLEG 21

__device__ __forceinline__ float wave_sum(float v) {
#pragma unroll
    for (int o = 1; o < 64; o <<= 1) v += __shfl_xor(v, o);
    return v;
}
__device__ __forceinline__ float wave_max(float v) {
#pragma unroll
    for (int o = 1; o < 64; o <<= 1) v = fmaxf(v, __shfl_xor(v, o));
    return v;
}
__device__ __forceinline__ float wave_min(float v) {
#pragma unroll
    for (int o = 1; o < 64; o <<= 1) v = fminf(v, __shfl_xor(v, o));
    return v;
}
__device__ __forceinline__ int wave_sum_i(int v) {
#pragma unroll
    for (int o = 1; o < 64; o <<= 1) v += __shfl_xor(v, o);
    return v;
}

__device__ __forceinline__ int dest_row(int mode, int n) {
    if (mode == 0) return n;
    if (mode == 2) return 8 * (n >> 2) + (n & 3);
    if (mode == 3) return 8 * (n >> 2) + 4 + (n & 3);
    if (n < 1024) { const int d = n & 63, base = n & ~63; return d < 32 ? base + 8 * (d >> 2) + (d & 3) : base + 8 * ((d - 32) >> 2) + 4 + (d & 3); }
    if (n < 2560) return n;
    if (n < 2688) return 3072 + (n - 2560);
    if (n < 3200) return 2560 + (n - 2688);
    return n;
}
__device__ __forceinline__ void transpose_item(const float* W, int K, int N, bf16* WT, int mode, LAS float* scr, int item, int lane) {
    const int nblk = (N + 31) / 32, kb = item / nblk, nb = item % nblk, k0 = 64 * kb, n0 = 32 * nb;
    const int nn = n0 + (lane & 31);
#pragma unroll 8
    for (int i = 0; i < 32; ++i) { const int kk = 2 * i + (lane >> 5); scr[kk * 33 + (lane & 31)] = (nn < N) ? W[(size_t)(k0 + kk) * N + nn] : 0.f; }
    LDS_WAIT(); asm volatile("" ::: "memory");
    const int c = lane & 7;
#pragma unroll
    for (int j = 0; j < 4; ++j) { const int nl = (lane >> 3) + 8 * j; const LAS float* s = scr + (8 * c) * 33 + nl;
        v4u o; o.x = pk2(s[0 * 33], s[1 * 33]); o.y = pk2(s[2 * 33], s[3 * 33]); o.z = pk2(s[4 * 33], s[5 * 33]); o.w = pk2(s[6 * 33], s[7 * 33]);
        if (n0 + nl < N) *(GAS v4u*)(WT + (size_t)dest_row(mode, n0 + nl) * K + k0 + 8 * c) = o; }
    LDS_WAIT(); asm volatile("" ::: "memory");
}
__device__ __forceinline__ void norm_row(int lane, const float* tmp, const float* xin, float* xout, const float* g_post, const float* g_next, bf16* act, bool plain) {
    f32x4 x[4];
#pragma unroll
    for (int j = 0; j < 4; ++j) x[j] = ((const GAS f32x4*)xin)[lane + 64 * j];
    if (tmp) {
        f32x4 t[4]; float ss = 0.f;
#pragma unroll
        for (int j = 0; j < 4; ++j) { t[j] = ((const GAS f32x4*)tmp)[lane + 64 * j]; ss += (t[j].x * t[j].x + t[j].y * t[j].y) + (t[j].z * t[j].z + t[j].w * t[j].w); }
        const float r = 1.0f / sqrtf(wave_sum(ss) * (1.f / DM) + EPS);
#pragma unroll
        for (int j = 0; j < 4; ++j) { const f32x4 g = ((const GAS f32x4*)g_post)[lane + 64 * j]; x[j] = x[j] + t[j] * r * g; }
    }
    if (xout) {
#pragma unroll
        for (int j = 0; j < 4; ++j) ((GAS f32x4*)xout)[lane + 64 * j] = x[j];
    }
    if (act) {
        if (g_next) {
            float ss = 0.f;
#pragma unroll
            for (int j = 0; j < 4; ++j) ss += (x[j].x * x[j].x + x[j].y * x[j].y) + (x[j].z * x[j].z + x[j].w * x[j].w);
            const float r = 1.0f / sqrtf(wave_sum(ss) * (1.f / DM) + EPS);
#pragma unroll
            for (int j = 0; j < 4; ++j) { const f32x4 g = ((const GAS f32x4*)g_next)[lane + 64 * j]; x[j] = x[j] * r * g; }
        }
        (void)plain;
#pragma unroll
        for (int j = 0; j < 4; ++j) { v2u o; o.x = pk2(x[j].x, x[j].y); o.y = pk2(x[j].z, x[j].w); ((GAS v2u*)act)[lane + 64 * j] = o; }
    }
}

__device__ __forceinline__ void p0_prologue(Frame& F, const Args& A) {
    LAS float* scr = (LAS float*)(F.lds + RING_OFF + F.wave * 16384);
    const int gw = blockIdx.x * NWAVES + F.wave, NGW = F.G * NWAVES;
    const int gt = blockIdx.x * NTHREADS + F.tid, NGT = F.G * NTHREADS;
    unsigned char* ws = F.ws;
    for (int l = 0; l < DEPTH; ++l) {
        for (int mat = 0; mat < 7; ++mat) {
            const float* W; int K, N, mode; bf16* WT;
            switch (mat) {
                case 0: W = INP(IN_WIN) + (size_t)l * DM * NIN; K = DM; N = NIN; mode = 1; WT = (bf16*)(ws + WS_WIN) + (size_t)l * NINP * DM; break;
                case 1: W = INP(IN_WOUT) + (size_t)l * DM * DM; K = DM; N = DM; mode = 0; WT = (bf16*)(ws + WS_WOUT) + (size_t)l * DM * DM; break;
                case 2: W = INP(IN_WGATE) + (size_t)l * DM * DFF; K = DM; N = DFF; mode = 2; WT = (bf16*)(ws + WS_WGU) + (size_t)l * NGU * DM; break;
                case 3: W = INP(IN_WUP) + (size_t)l * DM * DFF; K = DM; N = DFF; mode = 3; WT = (bf16*)(ws + WS_WGU) + (size_t)l * NGU * DM; break;
                case 4: W = INP(IN_WDOWN) + (size_t)l * DFF * DM; K = DFF; N = DM; mode = 0; WT = (bf16*)(ws + WS_WD) + (size_t)l * DM * DFF; break;
                case 5: W = INP(IN_WPU) + (size_t)l * PLE * DM; K = PLE; N = DM; mode = 0; WT = (bf16*)(ws + WS_WPU) + (size_t)l * DM * PLE; break;
                default: W = INP(IN_WPG) + (size_t)l * DM * DM; K = DM; N = DM; mode = 0; WT = (bf16*)(ws + WS_WPG) + (size_t)l * DM * DM; break;
            }
            const int nitems = (K / 64) * ((N + 31) / 32);
            for (int it = gw; it < nitems; it += NGW) transpose_item(W, K, N, WT, mode, scr, it, F.lane);
        }
        for (int hd = 0; hd < 8; ++hd) {
            for (int it = gw; it < 8; it += NGW) {
                if (it < 4) transpose_item(INP(IN_WUK) + (size_t)(l * 8 + hd) * 64 * 128, 64, 128, (bf16*)(ws + WS_WUK) + (size_t)(l * 8 + hd) * 128 * 64, 0, scr, it, F.lane);
                else transpose_item(INP(IN_WUV) + (size_t)(l * 8 + hd) * 128 * 64, 128, 64, (bf16*)(ws + WS_WUV) + (size_t)(l * 8 + hd) * 64 * 128, 0, scr, it - 4, F.lane);
            }
        }
        { GAS v4u* z = (GAS v4u*)((bf16*)(ws + WS_WIN) + (size_t)l * NINP * DM + (size_t)NIN * DM); const int n16 = (NINP - NIN) * DM * 2 / 16;
          for (int i = gt; i < n16; i += NGT) z[i] = (v4u){0u, 0u, 0u, 0u}; }
    }
    { const GAS f32x4* src = (const GAS f32x4*)INP(IN_P); GAS v4u* dst = (GAS v4u*)(ws + WS_PB); const int n8 = DEPTH * M * PLE / 8;
      for (int i = gt; i < n8; i += NGT) { const f32x4 a = src[2 * i], b = src[2 * i + 1]; v4u o; o.x = pk2(a.x, a.y); o.y = pk2(a.z, a.w); o.z = pk2(b.x, b.y); o.w = pk2(b.z, b.w); dst[i] = o; } }
    { const int* pos = (const int*)INP(IN_POS); float* ct = (float*)(ws + WS_COS); float* st = (float*)(ws + WS_SIN);
      for (int i = gt; i < M * 32; i += NGT) { const int row = i >> 5, j = i & 31; const double inv = exp(-(double)j * (9.210340371976184 / 32.0)); const double ang = (double)pos[row] * inv;
          ct[i] = (float)cos(ang); st[i] = (float)sin(ang); } }
    for (int m = gw; m < M; m += NGW) norm_row(F.lane, nullptr, INP(IN_X) + (size_t)m * DM, nullptr, nullptr, INP(IN_PREMIX), (bf16*)(ws + WS_ACT) + (size_t)m * DM, false);
}

__device__ __forceinline__ void postproj_phase(Frame& F, const Args& A, int l) {
    const int gw = blockIdx.x * NWAVES + F.wave, NGW = F.G * NWAVES, lane = F.lane;
    const float* misc = (const float*)(F.ws + WS_MISC);
    bf16* ckv = (bf16*)(F.ws + WS_CKV); bf16* ki = (bf16*)(F.ws + WS_KI); float* wi = (float*)(F.ws + WS_WI);
    const float* kvg = INP(IN_KVG) + l * 128; const float* ikg = INP(IN_IKG) + l * 64; const float* ikb = INP(IN_IKB) + l * 64;
    for (int m = gw; m < M; m += NGW) {
        const f32x4 v = ((const GAS f32x4*)(misc + (size_t)m * 256))[lane];
        const float sq = (v.x * v.x + v.y * v.y) + (v.z * v.z + v.w * v.w), sm = (v.x + v.y) + (v.z + v.w);
        const bool isk = (lane >= 32 && lane < 48);
        const float ssc = wave_sum(lane < 32 ? sq : 0.f);
        const float mu = wave_sum(isk ? sm : 0.f) * (1.f / 64.f);
        const f32x4 dv = v - mu;
        const float var = wave_sum(isk ? ((dv.x * dv.x + dv.y * dv.y) + (dv.z * dv.z + dv.w * dv.w)) : 0.f) * (1.f / 64.f);
        if (lane < 32) { const float r = 1.0f / sqrtf(ssc * (1.f / 128.f) + EPS); const f32x4 g = *(const f32x4*)(kvg + 4 * lane); const f32x4 o = v * r * g;
            v2u w; w.x = pk2(o.x, o.y); w.y = pk2(o.z, o.w); ((GAS v2u*)(ckv + (size_t)m * 128))[lane] = w; }
        else if (isk) { const float r = 1.0f / sqrtf(var + EPS); const int d = 4 * (lane - 32); const f32x4 g = *(const f32x4*)(ikg + d), bb = *(const f32x4*)(ikb + d); const f32x4 o = dv * r * g + bb;
            v2u w; w.x = pk2(o.x, o.y); w.y = pk2(o.z, o.w); ((GAS v2u*)(ki + (size_t)m * 64))[lane - 32] = w; }
        else if (lane < 50) { ((GAS f32x4*)(wi + (size_t)m * 8))[lane - 48] = v * 0.04419417382415922f; }
    }
}

__device__ __forceinline__ void ret_naive_phase(Frame& F, const Args& A, int l) {
    LAS float* Ks = (LAS float*)(F.lds + RING_OFF); LAS float* Vs = Ks + 32 * 64;
    const bf16* RQ = (const bf16*)(F.ws + WS_PROJ); const bf16* RK = RQ + (size_t)M * 512; const bf16* RV = RK + (size_t)M * 512; const bf16* RG = RV + (size_t)M * 512;
    bf16* CAT = (bf16*)(F.ws + WS_CAT);
    const int tid = F.tid;
    for (int item = blockIdx.x; item < 256; item += F.G) {
        const int b = item >> 5, h = (item >> 2) & 7, tq = item & 3;
        const int t = 4 * tid + tq; const size_t row = (size_t)b * SEQ + t;
        float q[64], acc[64];
#pragma unroll
        for (int c = 0; c < 8; ++c) { const v4u w = *(const GAS v4u*)(RQ + row * 512 + h * 64 + c * 8);
            q[8 * c + 0] = bf_lo(w.x); q[8 * c + 1] = bf_hi(w.x); q[8 * c + 2] = bf_lo(w.y); q[8 * c + 3] = bf_hi(w.y); q[8 * c + 4] = bf_lo(w.z); q[8 * c + 5] = bf_hi(w.z); q[8 * c + 6] = bf_lo(w.w); q[8 * c + 7] = bf_hi(w.w); }
#pragma unroll
        for (int e = 0; e < 64; ++e) acc[e] = 0.f;
        const float lg2 = log2f(1.0f - exp2f(-5.0f - (float)h));
        for (int s0 = 0; s0 < SEQ; s0 += 32) {
            __syncthreads();
            { const int which = tid >> 8, r = (tid & 255) >> 3, c8 = tid & 7; const bf16* src = (which ? RV : RK) + ((size_t)b * SEQ + s0 + r) * 512 + h * 64 + c8 * 8;
              const v4u w = *(const GAS v4u*)src; LAS float* d = (which ? Vs : Ks) + r * 64 + c8 * 8;
              d[0] = bf_lo(w.x); d[1] = bf_hi(w.x); d[2] = bf_lo(w.y); d[3] = bf_hi(w.y); d[4] = bf_lo(w.z); d[5] = bf_hi(w.z); d[6] = bf_lo(w.w); d[7] = bf_hi(w.w); }
            __syncthreads();
            for (int s = 0; s < 32; ++s) { const int sg = s0 + s;
                if (sg <= t) { float dot = 0.f;
#pragma unroll
                    for (int d = 0; d < 64; ++d) dot += q[d] * Ks[s * 64 + d];
                    const float w = dot * exp2f(lg2 * (float)(t - sg));
#pragma unroll
                    for (int e = 0; e < 64; ++e) acc[e] += w * Vs[s * 64 + e]; } }
        }
        float mu = 0.f;
#pragma unroll
        for (int e = 0; e < 64; ++e) mu += acc[e];
        mu *= (1.f / 64.f); float var = 0.f;
#pragma unroll
        for (int e = 0; e < 64; ++e) { const float d = acc[e] - mu; var += d * d; }
        const float r = 1.0f / sqrtf(var * (1.f / 64.f) + EPS);
        const float* g = INP(IN_RETG) + (l * 8 + h) * 64; const float* bb = INP(IN_RETB) + (l * 8 + h) * 64;
#pragma unroll
        for (int c = 0; c < 8; ++c) { const v4u gw = *(const GAS v4u*)(RG + row * 512 + h * 64 + c * 8); float y[8];
#pragma unroll
            for (int i = 0; i < 8; ++i) y[i] = (acc[8 * c + i] - mu) * r * g[8 * c + i] + bb[8 * c + i];
            v4u o; o.x = pk2(bf_lo(gw.x) * y[0], bf_hi(gw.x) * y[1]); o.y = pk2(bf_lo(gw.y) * y[2], bf_hi(gw.y) * y[3]); o.z = pk2(bf_lo(gw.z) * y[4], bf_hi(gw.z) * y[5]); o.w = pk2(bf_lo(gw.w) * y[6], bf_hi(gw.w) * y[7]);
            *(GAS v4u*)(CAT + row * 1024 + h * 64 + c * 8) = o; }
    }
    __syncthreads();
}

__device__ __forceinline__ void dsa_naive_phase(Frame& F, const Args& A, int l) {
    LAS float* S = (LAS float*)(F.lds + RING_OFF) + F.wave * 4096;
    LAS float* qiS = S; LAS float* aqS = S + 512; LAS float* qlS = S + 1024; LAS unsigned* kuS = (LAS unsigned*)(S + 2048); LAS float* oS = S;
    const bf16* AQ = (const bf16*)(F.ws + WS_PROJ) + (size_t)4 * M * 512; const bf16* IQ = AQ + (size_t)M * 512;
    const bf16* CKV = (const bf16*)(F.ws + WS_CKV); const bf16* KI = (const bf16*)(F.ws + WS_KI); const float* WI = (const float*)(F.ws + WS_WI);
    const float* wuk = INP(IN_WUK) + (size_t)l * 8 * 64 * 128; const float* wuv = INP(IN_WUV) + (size_t)l * 8 * 128 * 64;
    bf16* CAT = (bf16*)(F.ws + WS_CAT);
    const int lane = F.lane;
    for (int gw = blockIdx.x * NWAVES + F.wave; gw < SEQ; gw += F.G * NWAVES)
    for (int k = 0; k < BATCH; ++k) {
        const int b = k, t = (k & 1) ? (SEQ - 1 - gw) : gw; const size_t row = (size_t)b * SEQ + t;
        { const v4u w = *(const GAS v4u*)(IQ + row * 512 + 8 * lane); LAS float* d = qiS + 8 * lane;
          d[0] = bf_lo(w.x); d[1] = bf_hi(w.x); d[2] = bf_lo(w.y); d[3] = bf_hi(w.y); d[4] = bf_lo(w.z); d[5] = bf_hi(w.z); d[6] = bf_lo(w.w); d[7] = bf_hi(w.w);
          const v4u a = *(const GAS v4u*)(AQ + row * 512 + 8 * lane); LAS float* e = aqS + 8 * lane;
          e[0] = bf_lo(a.x); e[1] = bf_hi(a.x); e[2] = bf_lo(a.y); e[3] = bf_hi(a.y); e[4] = bf_lo(a.z); e[5] = bf_hi(a.z); e[6] = bf_lo(a.w); e[7] = bf_hi(a.w); }
        const float wiv = WI[row * 8 + (lane & 7)];
        LDS_WAIT(); asm volatile("" ::: "memory");
        for (int h = 0; h < 8; ++h) { float a0 = 0.f, a1 = 0.f;
            for (int d = 0; d < 64; ++d) { const float a = aqS[h * 64 + d]; const float* wr_ = wuk + ((size_t)h * 64 + d) * 128; a0 += a * wr_[lane]; a1 += a * wr_[64 + lane]; }
            qlS[h * 128 + lane] = a0 * 0.125f; qlS[h * 128 + 64 + lane] = a1 * 0.125f; }
        for (int i = 0; i < 32; ++i) kuS[lane + 64 * i] = 0u;
        LDS_WAIT(); asm volatile("" ::: "memory");
        for (int i = 0; 64 * i <= t; ++i) { const int s = lane + 64 * i; const bf16* kr = KI + ((size_t)b * SEQ + s) * 64; float kf[64];
#pragma unroll
            for (int c = 0; c < 8; ++c) { const v4u w = *(const GAS v4u*)(kr + 8 * c);
                kf[8 * c + 0] = bf_lo(w.x); kf[8 * c + 1] = bf_hi(w.x); kf[8 * c + 2] = bf_lo(w.y); kf[8 * c + 3] = bf_hi(w.y); kf[8 * c + 4] = bf_lo(w.z); kf[8 * c + 5] = bf_hi(w.z); kf[8 * c + 6] = bf_lo(w.w); kf[8 * c + 7] = bf_hi(w.w); }
            float tot = 0.f;
            for (int h = 0; h < 8; ++h) { float dot = 0.f;
#pragma unroll
                for (int d = 0; d < 64; ++d) dot += qiS[h * 64 + d] * kf[d];
                tot += __shfl(wiv, h) * fmaxf(dot, 0.f); }
            const float v = tot + 0.0f; const unsigned u = __float_as_uint(v);
            if (s <= t) kuS[s] = (u & 0x80000000u) ? ~u : (u | 0x80000000u); }
        LDS_WAIT(); asm volatile("" ::: "memory");
        unsigned ku[32];
#pragma unroll
        for (int i = 0; i < 32; ++i) ku[i] = kuS[lane + 64 * i];
        const int kk = (t + 1 < 256) ? (t + 1) : 256;
        unsigned thr = 0u, tiekey = 0u; int need = 0;
        if (t + 1 > 256) {
            unsigned lo = 0u, hi = 0xFFFFFFFFu; bool exact = false;
            while (hi - lo > 1u) {
                const unsigned mid = lo + ((hi - lo) >> 1);
                int c = 0;
#pragma unroll
                for (int i = 0; i < 32; ++i) c += (ku[i] > mid) ? 1 : 0;
                c = wave_sum_i(c);
                if (c == kk) { thr = mid; exact = true; break; }
                if (c > kk) lo = mid; else hi = mid;
            }
            if (!exact) { int c = 0;
#pragma unroll
                for (int i = 0; i < 32; ++i) c += (ku[i] > hi) ? 1 : 0;
                c = wave_sum_i(c); thr = hi; tiekey = hi; need = kk - c; }
        }
        unsigned selm = 0u; int run = 0;
#pragma unroll
        for (int i = 0; i < 32; ++i) {
            bool sl = ku[i] > thr;
            if (need > 0) { const bool tie = (ku[i] == tiekey); const unsigned long long tb = __ballot(tie);
                const int rank = run + __popcll(tb & ((1ull << lane) - 1ull)); if (tie && rank < need) sl = true; run += __popcll(tb); }
            selm |= sl ? (1u << i) : 0u;
        }
        LAS float* pS = (LAS float*)kuS;
        for (int h = 0; h < 8; ++h) {
            float mx = -INFINITY;
            for (int i = 0; 64 * i <= t; ++i) { float dot = -INFINITY;
                if ((selm >> i) & 1u) { const int s = lane + 64 * i; const bf16* cr = CKV + ((size_t)b * SEQ + s) * 128; dot = 0.f;
#pragma unroll 4
                    for (int c4 = 0; c4 < 16; ++c4) { const v4u w = *(const GAS v4u*)(cr + 8 * c4); const LAS float* qq = qlS + h * 128 + 8 * c4;
                        dot += qq[0] * bf_lo(w.x) + qq[1] * bf_hi(w.x) + qq[2] * bf_lo(w.y) + qq[3] * bf_hi(w.y) + qq[4] * bf_lo(w.z) + qq[5] * bf_hi(w.z) + qq[6] * bf_lo(w.w) + qq[7] * bf_hi(w.w); }
                    mx = fmaxf(mx, dot); }
                pS[lane + 64 * i] = dot; }
            mx = wave_max(mx);
            float sum = 0.f;
            for (int i = 0; 64 * i <= t; ++i) { const float lgv = pS[lane + 64 * i]; const float p = ((selm >> i) & 1u) ? __expf(lgv - mx) : 0.f; pS[lane + 64 * i] = p; sum += p; }
            sum = wave_sum(sum);
            LDS_WAIT(); asm volatile("" ::: "memory");
            float o0 = 0.f, o1 = 0.f;
            for (int i = 0; 64 * i <= t; ++i) { unsigned long long mbits = __ballot((selm >> i) & 1u);
                while (mbits) { const int bit = __ffsll((long long)mbits) - 1; mbits &= mbits - 1ull; const float ps = pS[bit + 64 * i];
                    const unsigned w = ((const GAS unsigned*)(CKV + ((size_t)b * SEQ + bit + 64 * i) * 128))[lane]; o0 += ps * bf_lo(w); o1 += ps * bf_hi(w); } }
            LDS_WAIT(); asm volatile("" ::: "memory");
            const float inv = 1.0f / sum;
            oS[h * 128 + 2 * lane] = o0 * inv; oS[h * 128 + 2 * lane + 1] = o1 * inv;
        }
        LDS_WAIT(); asm volatile("" ::: "memory");
        for (int h = 0; h < 8; ++h) { float a = 0.f;
            for (int c = 0; c < 128; ++c) a += oS[h * 128 + c] * wuv[((size_t)h * 128 + c) * 64 + lane];
            CAT[row * 1024 + 512 + h * 64 + lane] = (bf16)f2bf(a); }
        LDS_WAIT(); asm volatile("" ::: "memory");
    }
}

__device__ __forceinline__ void norm_phase(Frame& F, const float* tmp, const float* xin, float* xout, const float* g_post, const float* g_next, bf16* act) {
    const int gw = blockIdx.x * NWAVES + F.wave, NGW = F.G * NWAVES;
    for (int m = gw; m < M; m += NGW) norm_row(F.lane, tmp + (size_t)m * DM, xin + (size_t)m * DM, xout + (size_t)m * DM, g_post, g_next, act ? act + (size_t)m * DM : nullptr, false);
}

typedef float f32x16 __attribute__((ext_vector_type(16)));
typedef short v4i16_t __attribute__((ext_vector_type(4)));
#define MFMA32(a, b, c) __builtin_amdgcn_mfma_f32_32x32x16_bf16((a), (b), (c), 0, 0, 0)
__device__ __forceinline__ unsigned off_b(unsigned row, unsigned ch) { return 256u * row + 16u * (ch ^ (((row & 3) << 2) | ((row >> 2) & 3))); }
__device__ __forceinline__ unsigned row_read_addr(unsigned lane, unsigned s) { return off_b(lane & 31, 2 * s + (lane >> 5)); }
__device__ __forceinline__ unsigned tr_read_addr_acc(unsigned lane, unsigned c, unsigned rbase) {
    const unsigned h = lane >> 5, blk = (lane >> 4) & 1, q = (lane & 15) >> 2, p = lane & 3;
    return off_b(rbase + 4 * h + q, 4 * c + 2 * blk + (p >> 1)) + 8 * (p & 1);
}
__device__ __forceinline__ v4i16_t lds_tr(LAS unsigned char* p) { return __builtin_amdgcn_ds_read_tr16_b64_v4i16((LAS v4i16_t*)p); }
__device__ __forceinline__ unsigned cvtpk(float lo, float hi) { typedef float f2 __attribute__((ext_vector_type(2))); typedef __bf16 b2 __attribute__((ext_vector_type(2))); f2 v = {lo, hi}; b2 b = __builtin_convertvector(v, b2); return __builtin_bit_cast(unsigned, b); }
__device__ __forceinline__ float xhalf_max(float v) { auto rr = __builtin_amdgcn_permlane32_swap(__float_as_uint(v), __float_as_uint(v), false, false); return fmaxf(__uint_as_float(rr[0]), __uint_as_float(rr[1])); }
__device__ __forceinline__ float xhalf_sum(float v) { auto rr = __builtin_amdgcn_permlane32_swap(__float_as_uint(v), __float_as_uint(v), false, false); return __uint_as_float(rr[0]) + __uint_as_float(rr[1]); }
__device__ __forceinline__ int half_sum_i(int v) {
#pragma unroll
    for (int o = 1; o < 32; o <<= 1) v += __shfl_xor(v, o);
    return v;
}
__device__ __forceinline__ unsigned mono_key(float s) { const float v = s + 0.0f; const unsigned u = __float_as_uint(v); return (u & 0x80000000u) ? ~u : (u | 0x80000000u); }

__device__ __forceinline__ int launder(int x) { asm volatile("" : "+v"(x)); return x; }
constexpr int DSA_QL = 0;
constexpr int DSA_MASK = 65536;
constexpr int DSA_CT = 73728;
constexpr float LOG2E = 1.4426950408889634f;

__device__ __forceinline__ void dsa_item(Frame& F, const Args& A, const int l, const int b, const int qt) {
    const int w = F.wave;
    const int t0 = 32 * qt; const size_t rowbase = (size_t)b * SEQ;
    LAS unsigned char* lds = F.lds + RING_OFF;
    const bf16* AQ = (const bf16*)(F.ws + WS_PROJ) + (size_t)4 * M * 512; const bf16* IQ = AQ + (size_t)M * 512;
    const bf16* CKV = (const bf16*)(F.ws + WS_CKV); const bf16* KI = (const bf16*)(F.ws + WS_KI); const float* WI = (const float*)(F.ws + WS_WI);
    const bf16* WUKT = (const bf16*)(F.ws + WS_WUK) + (size_t)l * 8 * 128 * 64; const bf16* WUVT = (const bf16*)(F.ws + WS_WUV) + (size_t)l * 8 * 64 * 128;
    bf16* CAT = (bf16*)(F.ws + WS_CAT);
    LAS unsigned* MASK = (LAS unsigned*)(lds + DSA_MASK);

    {
        const int lane = launder(F.lane), r = lane & 31, hh = lane >> 5;
        bf16x8 bq[4];
#pragma unroll
        for (int ks = 0; ks < 4; ++ks) bq[ks] = *(const GAS bf16x8*)(AQ + (rowbase + t0 + r) * 512 + w * 64 + 16 * ks + 8 * hh);
#pragma unroll
        for (int cb = 0; cb < 4; ++cb) {
            f32x16 acc = {};
#pragma unroll
            for (int ks = 0; ks < 4; ++ks) { const bf16x8 af = *(const GAS bf16x8*)(WUKT + ((size_t)(w * 128 + 32 * cb + r)) * 64 + 16 * ks + 8 * hh); acc = MFMA32(af, bq[ks], acc); }
            const int q = r; LAS unsigned char* rowp = lds + DSA_QL + 8192 * (q >> 2);
            const unsigned n = (unsigned)((q & 3) * 8 + w);
#pragma unroll
            for (int rg = 0; rg < 4; ++rg) { v2u o; o.x = cvtpk(acc[4 * rg] * (0.125f * LOG2E), acc[4 * rg + 1] * (0.125f * LOG2E)); o.y = cvtpk(acc[4 * rg + 2] * (0.125f * LOG2E), acc[4 * rg + 3] * (0.125f * LOG2E));
                *(LAS v2u*)(rowp + off_b(n, 4 * cb + rg) + 8 * hh) = o; }
        }
    }
    __syncthreads();

    {
        const int lane = launder(F.lane), r = lane & 31, hh = lane >> 5;
        const int ql_a = 2 * ((r >> 2) & 1) + (r >> 4), hd_a = 4 * ((r >> 3) & 1) + (r & 3);
        bf16x8 aiq[4];
#pragma unroll
        for (int ks = 0; ks < 4; ++ks) aiq[ks] = *(const GAS bf16x8*)(IQ + (rowbase + t0 + 4 * w + ql_a) * 512 + hd_a * 64 + 16 * ks + 8 * hh);
        float wv[16];
#pragma unroll
        for (int a = 0; a < 2; ++a) { const GAS f32x4* wp = (const GAS f32x4*)(WI + (rowbase + t0 + 4 * w + 2 * hh + a) * 8); const f32x4 w0 = wp[0], w1 = wp[1];
            wv[8 * a + 0] = w0.x; wv[8 * a + 1] = w0.y; wv[8 * a + 2] = w0.z; wv[8 * a + 3] = w0.w; wv[8 * a + 4] = w1.x; wv[8 * a + 5] = w1.y; wv[8 * a + 6] = w1.z; wv[8 * a + 7] = w1.w; }
        unsigned ku[2][64];
        const int tq0 = t0 + 4 * w + 2 * hh;
        bf16x8 bk[4];
#pragma unroll
        for (int ks = 0; ks < 4; ++ks) bk[ks] = *(const GAS bf16x8*)(KI + (rowbase + r) * 64 + 16 * ks + 8 * hh);
#pragma unroll
        for (int kb = 0; kb < 64; ++kb) {
            ku[0][kb] = 0u; ku[1][kb] = 0u;
            if (kb <= qt) {
                bf16x8 bn[4];
                const int kbn = (kb < qt) ? kb + 1 : kb;
#pragma unroll
                for (int ks = 0; ks < 4; ++ks) bn[ks] = *(const GAS bf16x8*)(KI + (rowbase + 32 * kbn + r) * 64 + 16 * ks + 8 * hh);
                f32x16 acc = {};
#pragma unroll
                for (int ks = 0; ks < 4; ++ks) acc = MFMA32(aiq[ks], bk[ks], acc);
                float s0 = 0.f, s1 = 0.f;
#pragma unroll
                for (int h = 0; h < 8; ++h) { s0 += wv[h] * fmaxf(acc[h], 0.f); s1 += wv[8 + h] * fmaxf(acc[8 + h], 0.f); }
                const int key = 32 * kb + r;
                unsigned k0 = (key <= tq0) ? mono_key(s0) : 0u, k1 = (key <= tq0 + 1) ? mono_key(s1) : 0u;
                asm volatile("" : "+v"(k0), "+v"(k1));
                ku[0][kb] = k0; ku[1][kb] = k1;
#pragma unroll
                for (int ks = 0; ks < 4; ++ks) bk[ks] = bn[ks];
                __builtin_amdgcn_sched_barrier(0);
            }
        }
        unsigned thr[2], tiek[2]; int need[2];
        {
            unsigned lo[2] = {0u, 0u}, hi[2] = {0xFFFFFFFFu, 0xFFFFFFFFu}; bool done[2]; int kk[2];
#pragma unroll
            for (int a = 0; a < 2; ++a) { const int t = tq0 + a; kk[a] = (t + 1 < 256) ? (t + 1) : 256; done[a] = (t + 1 <= 256); thr[a] = 0u; tiek[a] = 0u; need[a] = 0; }
            while (__any(!done[0] || !done[1])) {
                const unsigned m0 = lo[0] + ((hi[0] - lo[0]) >> 1), m1 = lo[1] + ((hi[1] - lo[1]) >> 1);
                int ca = 0, cb_ = 0;
#pragma unroll
                for (int kb = 0; kb < 64; ++kb) { ca += (ku[0][kb] > m0) ? 1 : 0; cb_ += (ku[1][kb] > m1) ? 1 : 0; }
                const int c = half_sum_i(ca + (cb_ << 16));
                const int c0 = c & 0xffff, c1 = c >> 16;
                if (!done[0]) { if (c0 == kk[0]) { thr[0] = m0; done[0] = true; } else if (c0 > kk[0]) lo[0] = m0; else hi[0] = m0;
                    if (!done[0] && hi[0] - lo[0] <= 1u) { done[0] = true; thr[0] = hi[0]; tiek[0] = hi[0]; need[0] = -1; } }
                if (!done[1]) { if (c1 == kk[1]) { thr[1] = m1; done[1] = true; } else if (c1 > kk[1]) lo[1] = m1; else hi[1] = m1;
                    if (!done[1] && hi[1] - lo[1] <= 1u) { done[1] = true; thr[1] = hi[1]; tiek[1] = hi[1]; need[1] = -1; } }
            }
            if (__any(need[0] < 0 || need[1] < 0)) {
                int ca = 0, cb_ = 0;
#pragma unroll
                for (int kb = 0; kb < 64; ++kb) { ca += (ku[0][kb] > thr[0]) ? 1 : 0; cb_ += (ku[1][kb] > thr[1]) ? 1 : 0; }
                const int c = half_sum_i(ca + (cb_ << 16));
                if (need[0] < 0) need[0] = kk[0] - (c & 0xffff);
                if (need[1] < 0) need[1] = kk[1] - (c >> 16);
            }
        }
        const bool anytie = __any(need[0] > 0 || need[1] > 0);
        int run0 = 0, run1 = 0;
        unsigned wq0[2] = {0u, 0u}, wq1[2] = {0u, 0u};
#pragma unroll
        for (int kb = 0; kb < 64; ++kb) {
            if (kb <= qt) {
                unsigned ka = ku[0][kb], kc = ku[1][kb];
                asm volatile("" : "+v"(ka), "+v"(kc));
                bool s0 = ka > thr[0], s1 = kc > thr[1];
                if (anytie) {
                    const bool t0b = (need[0] > 0) && (ka == tiek[0]), t1b = (need[1] > 0) && (kc == tiek[1]);
                    const unsigned long long b0 = __ballot(t0b), b1 = __ballot(t1b);
                    const unsigned h0 = hh ? (unsigned)(b0 >> 32) : (unsigned)b0, h1 = hh ? (unsigned)(b1 >> 32) : (unsigned)b1;
                    const unsigned below = (1u << r) - 1u;
                    if (t0b && run0 + __popc(h0 & below) < need[0]) s0 = true;
                    if (t1b && run1 + __popc(h1 & below) < need[1]) s1 = true;
                    run0 += __popc(h0); run1 += __popc(h1);
                }
                const unsigned long long m0 = __ballot(s0), m1 = __ballot(s1);
                const unsigned x0 = hh ? (unsigned)(m0 >> 32) : (unsigned)m0, x1 = hh ? (unsigned)(m1 >> 32) : (unsigned)m1;
                if (r == (kb & 31)) { wq0[kb >> 5] = x0; wq1[kb >> 5] = x1; }
            }
        }
#pragma unroll
        for (int j = 0; j < 2; ++j) { MASK[(4 * w + 2 * hh + 0) * 64 + 32 * j + r] = wq0[j]; MASK[(4 * w + 2 * hh + 1) * 64 + 32 * j + r] = wq1[j]; }
    }
    LDS_WAIT(); asm volatile("" ::: "memory");
    const int lane = launder(F.lane), r = lane & 31, hh = lane >> 5, tid = launder(F.tid);
    bf16x8 qf[8];
#pragma unroll
    for (int ks = 0; ks < 8; ++ks) qf[ks] = *(const LAS bf16x8*)(lds + DSA_QL + 8192 * w + row_read_addr(lane, ks));

    f32x16 o[4];
#pragma unroll
    for (int cb = 0; cb < 4; ++cb) o[cb] = (f32x16){};
    float mrun = -1e30f, lrun = 0.f;
    const LAS unsigned* mrow = MASK + (4 * w + (r >> 3)) * 64;
    {
        const int row = tid >> 4, ch = tid & 15;
        const v4u v = *(const GAS v4u*)(CKV + (rowbase + row) * 128 + 8 * ch);
        *(LAS v4u*)(lds + DSA_CT + off_b(row, ch)) = v;
    }
    __syncthreads();
    for (int kb = 0; kb <= qt; ++kb) {
        LAS unsigned char* ct = lds + DSA_CT + 8192 * (kb & 1);
        v4u nxt = {0u, 0u, 0u, 0u};
        if (kb < qt) { const int row = tid >> 4, ch = tid & 15; nxt = *(const GAS v4u*)(CKV + (rowbase + 32 * (kb + 1) + row) * 128 + 8 * ch); }
        f32x16 s = {};
#pragma unroll
        for (int ks = 0; ks < 8; ++ks) { const bf16x8 cf = *(const LAS bf16x8*)(ct + row_read_addr(lane, ks)); s = MFMA32(cf, qf[ks], s); }
        const unsigned mw = mrow[kb];
        float rm = -1e30f;
#pragma unroll
        for (int rg = 0; rg < 16; ++rg) { const int keyl = (rg & 3) + 8 * (rg >> 2) + 4 * hh; const bool sel = (mw >> keyl) & 1u; s[rg] = sel ? s[rg] : -1e30f; rm = fmaxf(rm, s[rg]); }
        rm = xhalf_max(rm);
        if (__any(rm > mrun + 8.0f)) {
            const float mn = (rm > mrun + 8.0f) ? rm : mrun; const float al = __builtin_amdgcn_exp2f(mrun - mn); mrun = mn; lrun *= al;
#pragma unroll
            for (int cb = 0; cb < 4; ++cb) o[cb] = o[cb] * al;
        }
        float ps = 0.f;
#pragma unroll
        for (int rg = 0; rg < 16; ++rg) { const float p = (s[rg] > -1e29f) ? __builtin_amdgcn_exp2f(s[rg] - mrun) : 0.f; s[rg] = p; ps += p; }
        lrun += ps;
        v4u pw[2];
#pragma unroll
        for (int sp = 0; sp < 2; ++sp) { pw[sp].x = cvtpk(s[8 * sp + 0], s[8 * sp + 1]); pw[sp].y = cvtpk(s[8 * sp + 2], s[8 * sp + 3]); pw[sp].z = cvtpk(s[8 * sp + 4], s[8 * sp + 5]); pw[sp].w = cvtpk(s[8 * sp + 6], s[8 * sp + 7]); }
#pragma unroll
        for (int cb = 0; cb < 4; ++cb)
#pragma unroll
            for (int sp = 0; sp < 2; ++sp) {
                const v4i16_t lo4 = lds_tr(ct + tr_read_addr_acc(lane, cb, 16 * sp)), hi4 = lds_tr(ct + tr_read_addr_acc(lane, cb, 16 * sp + 8));
                const bf16x8 af = {lo4[0], lo4[1], lo4[2], lo4[3], hi4[0], hi4[1], hi4[2], hi4[3]};
                o[cb] = MFMA32(af, __builtin_bit_cast(bf16x8, pw[sp]), o[cb]);
            }
        if (kb < qt) { const int row = tid >> 4, ch = tid & 15; *(LAS v4u*)(lds + DSA_CT + 8192 * ((kb + 1) & 1) + off_b(row, ch)) = nxt; }
        __syncthreads();
    }
    {
        const int lane2 = launder(F.lane), r = lane2 & 31, hh = lane2 >> 5;
        const float inv = 1.0f / xhalf_sum(lrun);
        LAS unsigned char* rowp = lds + DSA_QL + 8192 * w;
#pragma unroll
        for (int cb = 0; cb < 4; ++cb)
#pragma unroll
            for (int rg = 0; rg < 4; ++rg) { v2u ov; ov.x = cvtpk(o[cb][4 * rg] * inv, o[cb][4 * rg + 1] * inv); ov.y = cvtpk(o[cb][4 * rg + 2] * inv, o[cb][4 * rg + 3] * inv);
                *(LAS v2u*)(rowp + off_b((unsigned)r, 4 * cb + rg) + 8 * hh) = ov; }
    }
    __syncthreads();
    {
        const int lane2 = launder(F.lane), r = lane2 & 31, hh = lane2 >> 5;
        const int q = r; const LAS unsigned char* rowp = lds + DSA_QL + 8192 * (q >> 2); const unsigned n = (unsigned)((q & 3) * 8 + w);
        bf16x8 bo[8];
#pragma unroll
        for (int ks = 0; ks < 8; ++ks) bo[ks] = *(const LAS bf16x8*)(rowp + off_b(n, 2 * ks + hh));
#pragma unroll
        for (int db = 0; db < 2; ++db) {
            f32x16 acc = {};
#pragma unroll
            for (int ks = 0; ks < 8; ++ks) { const bf16x8 af = *(const GAS bf16x8*)(WUVT + ((size_t)(w * 64 + 32 * db + r)) * 128 + 16 * ks + 8 * hh); acc = MFMA32(af, bo[ks], acc); }
            bf16* dst = CAT + (rowbase + t0 + q) * 1024 + 512 + w * 64 + 32 * db + 4 * hh;
#pragma unroll
            for (int rg = 0; rg < 4; ++rg) { v2u ov; ov.x = cvtpk(acc[4 * rg], acc[4 * rg + 1]); ov.y = cvtpk(acc[4 * rg + 2], acc[4 * rg + 3]); *(GAS v2u*)(dst + 8 * rg) = ov; }
        }
    }
    __syncthreads();
}
__device__ __forceinline__ void dsa_fast_phase(Frame& F, const Args& A, const int l) {
    for (int c = blockIdx.x; c < 256; c += F.G) {
        const int b = c >> 5, qa = c & 31;
        dsa_item(F, A, l, b, qa);
        dsa_item(F, A, l, b, 63 - qa);
    }
}

__device__ __forceinline__ unsigned off64(unsigned row, unsigned ch) { return 128u * row + 16u * (ch ^ (row & 7u)); }
__device__ __forceinline__ unsigned tr_addr64(unsigned lane, unsigned c, unsigned rowh) {
    const unsigned blk = (lane >> 4) & 1, q = (lane & 15) >> 2, p = lane & 3;
    return off64(rowh + q, 4 * c + 2 * blk + (p >> 1)) + 8 * (p & 1);
}
constexpr int RET_K = 0, RET_V = 16384, RET_LN = 32768;

__device__ __forceinline__ void ret_state_item(Frame& F, const int b, const int h) {
    LAS unsigned char* lds = F.lds + RING_OFF;
    const bf16* RK = (const bf16*)(F.ws + WS_PROJ) + (size_t)M * 512; const bf16* RV = RK + (size_t)M * 512;
    bf16* RST = (bf16*)(F.ws + WS_RST);
    const int tid = launder(F.tid), lane = tid & 63, w = F.wave, r = lane & 31, hh = lane >> 5;
    const float lg2 = log2f(1.0f - exp2f(-5.0f - (float)h));
    const float gC = exp2f(lg2 * 128.0f);
    const int srow = tid >> 2, sch = (tid & 3) * 2;
    const float zeta = exp2f(lg2 * (float)(127 - srow));
    const size_t rowbase = (size_t)b * SEQ;
    f32x16 R = {};
    const int eb = w & 1, db = (w >> 1) & 1;
    v4u k0, k1, v0, v1;
    { const bf16* kp = RK + (rowbase + srow) * 512 + h * 64 + sch * 8; const bf16* vp = RV + (rowbase + srow) * 512 + h * 64 + sch * 8;
      k0 = *(const GAS v4u*)kp; k1 = *(const GAS v4u*)(kp + 8); v0 = *(const GAS v4u*)vp; v1 = *(const GAS v4u*)(vp + 8); }
    for (int n = 0; n < 16; ++n) {
        { v4u a, c;
          a.x = pk2(bf_lo(k0.x) * zeta, bf_hi(k0.x) * zeta); a.y = pk2(bf_lo(k0.y) * zeta, bf_hi(k0.y) * zeta); a.z = pk2(bf_lo(k0.z) * zeta, bf_hi(k0.z) * zeta); a.w = pk2(bf_lo(k0.w) * zeta, bf_hi(k0.w) * zeta);
          c.x = pk2(bf_lo(k1.x) * zeta, bf_hi(k1.x) * zeta); c.y = pk2(bf_lo(k1.y) * zeta, bf_hi(k1.y) * zeta); c.z = pk2(bf_lo(k1.z) * zeta, bf_hi(k1.z) * zeta); c.w = pk2(bf_lo(k1.w) * zeta, bf_hi(k1.w) * zeta);
          *(LAS v4u*)(lds + RET_K + off64(srow, sch)) = a; *(LAS v4u*)(lds + RET_K + off64(srow, sch + 1)) = c;
          *(LAS v4u*)(lds + RET_V + off64(srow, sch)) = v0; *(LAS v4u*)(lds + RET_V + off64(srow, sch + 1)) = v1; }
        __syncthreads();
        if (n + 1 < 16) { const bf16* kp = RK + (rowbase + (n + 1) * 128 + srow) * 512 + h * 64 + sch * 8; const bf16* vp = RV + (rowbase + (n + 1) * 128 + srow) * 512 + h * 64 + sch * 8;
            k0 = *(const GAS v4u*)kp; k1 = *(const GAS v4u*)(kp + 8); v0 = *(const GAS v4u*)vp; v1 = *(const GAS v4u*)(vp + 8); }
        if (w < 4) {
            bf16* dst = RST + ((size_t)((b * 16 + n) * 8 + h)) * 4096 + (size_t)(32 * eb + 4 * hh) * 64 + 32 * db + r;
#pragma unroll
            for (int rg = 0; rg < 16; ++rg) dst[((rg & 3) + 8 * (rg >> 2)) * 64] = (bf16)f2bf(R[rg]);
            f32x16 kv = {};
#pragma unroll
            for (int ks = 0; ks < 8; ++ks) {
                const v4i16_t a0 = lds_tr(lds + RET_V + tr_addr64(lane, eb, 16 * ks + 8 * hh)), a1 = lds_tr(lds + RET_V + tr_addr64(lane, eb, 16 * ks + 8 * hh + 4));
                const v4i16_t b0 = lds_tr(lds + RET_K + tr_addr64(lane, db, 16 * ks + 8 * hh)), b1 = lds_tr(lds + RET_K + tr_addr64(lane, db, 16 * ks + 8 * hh + 4));
                const bf16x8 af = {a0[0], a0[1], a0[2], a0[3], a1[0], a1[1], a1[2], a1[3]}, bfr = {b0[0], b0[1], b0[2], b0[3], b1[0], b1[1], b1[2], b1[3]};
                kv = MFMA32(af, bfr, kv);
            }
            R = R * gC + kv;
        }
        __syncthreads();
    }
}

__device__ __forceinline__ void ret_item(Frame& F, const Args& A, const int l, const int b, const int n, const int h) {
    LAS unsigned char* lds = F.lds + RING_OFF;
    const bf16* RQ = (const bf16*)(F.ws + WS_PROJ); const bf16* RK = RQ + (size_t)M * 512; const bf16* RV = RK + (size_t)M * 512; const bf16* RG = RV + (size_t)M * 512;
    const bf16* RST = (const bf16*)(F.ws + WS_RST) + ((size_t)((b * 16 + n) * 8 + h)) * 4096;
    bf16* CAT = (bf16*)(F.ws + WS_CAT);
    const int tid = launder(F.tid), lane = tid & 63, w = F.wave, r = lane & 31, hh = lane >> 5;
    const int qb = w & 3, eb = w >> 2;
    const float lg2 = log2f(1.0f - exp2f(-5.0f - (float)h));
    const size_t row0 = (size_t)b * SEQ + n * 128;
    { const int srow = tid >> 2, sch = (tid & 3) * 2; const bf16* kp = RK + (row0 + srow) * 512 + h * 64 + sch * 8; const bf16* vp = RV + (row0 + srow) * 512 + h * 64 + sch * 8;
      const v4u k0 = *(const GAS v4u*)kp, k1 = *(const GAS v4u*)(kp + 8), v0 = *(const GAS v4u*)vp, v1 = *(const GAS v4u*)(vp + 8);
      *(LAS v4u*)(lds + RET_K + off64(srow, sch)) = k0; *(LAS v4u*)(lds + RET_K + off64(srow, sch + 1)) = k1;
      *(LAS v4u*)(lds + RET_V + off64(srow, sch)) = v0; *(LAS v4u*)(lds + RET_V + off64(srow, sch + 1)) = v1; }
    bf16x8 qfr[4];
#pragma unroll
    for (int s = 0; s < 4; ++s) qfr[s] = *(const GAS bf16x8*)(RQ + (row0 + 32 * qb + r) * 512 + h * 64 + 16 * s + 8 * hh);
    f32x16 o = {};
#pragma unroll
    for (int s = 0; s < 4; ++s) { const bf16x8 rf = *(const GAS bf16x8*)(RST + (size_t)(32 * eb + r) * 64 + 16 * s + 8 * hh); o = MFMA32(rf, qfr[s], o); }
    { const float xi = exp2f(lg2 * (float)(32 * qb + r + 1)); o = o * xi; }
    __syncthreads();
    const int i_abs = 32 * qb + r;
    for (int jb = 0; jb <= qb; ++jb) {
        f32x16 s = {};
#pragma unroll
        for (int ks = 0; ks < 4; ++ks) { const bf16x8 kf = *(const LAS bf16x8*)(lds + RET_K + off64(32 * jb + r, 2 * ks + hh)); s = MFMA32(kf, qfr[ks], s); }
#pragma unroll
        for (int rg = 0; rg < 16; ++rg) { const int j = 32 * jb + (rg & 3) + 8 * (rg >> 2) + 4 * hh; const int diff = i_abs - j; s[rg] = (diff >= 0) ? s[rg] * exp2f(lg2 * (float)diff) : 0.f; }
#pragma unroll
        for (int sp = 0; sp < 2; ++sp) {
            v4u pw; pw.x = cvtpk(s[8 * sp + 0], s[8 * sp + 1]); pw.y = cvtpk(s[8 * sp + 2], s[8 * sp + 3]); pw.z = cvtpk(s[8 * sp + 4], s[8 * sp + 5]); pw.w = cvtpk(s[8 * sp + 6], s[8 * sp + 7]);
            const v4i16_t a0 = lds_tr(lds + RET_V + tr_addr64(lane, eb, 32 * jb + 16 * sp + 4 * hh)), a1 = lds_tr(lds + RET_V + tr_addr64(lane, eb, 32 * jb + 16 * sp + 8 + 4 * hh));
            const bf16x8 af = {a0[0], a0[1], a0[2], a0[3], a1[0], a1[1], a1[2], a1[3]};
            o = MFMA32(af, __builtin_bit_cast(bf16x8, pw), o);
        }
    }
    float s1 = 0.f, s2 = 0.f;
#pragma unroll
    for (int rg = 0; rg < 16; ++rg) { s1 += o[rg]; s2 += o[rg] * o[rg]; }
    s1 = xhalf_sum(s1); s2 = xhalf_sum(s2);
    typedef float f32x2v __attribute__((ext_vector_type(2)));
    LAS f32x2v* LN = (LAS f32x2v*)(lds + RET_LN);
    if (hh == 0) LN[w * 32 + r] = (f32x2v){s1, s2};
    __syncthreads();
    { const f32x2v p = LN[(w ^ 4) * 32 + r]; s1 += p.x; s2 += p.y; }
    const float mu = s1 * (1.f / 64.f); const float var = fmaxf(s2 * (1.f / 64.f) - mu * mu, 0.f); const float rstd = 1.0f / sqrtf(var + EPS);
    const float* g = INP(IN_RETG) + (l * 8 + h) * 64; const float* bb = INP(IN_RETB) + (l * 8 + h) * 64;
    const size_t orow = row0 + 32 * qb + r;
#pragma unroll
    for (int r4 = 0; r4 < 4; ++r4) { const int e = 32 * eb + 8 * r4 + 4 * hh;
        const f32x4 gv = *(const f32x4*)(g + e), bv = *(const f32x4*)(bb + e); const v2u gt = *(const GAS v2u*)(RG + orow * 512 + h * 64 + e);
        const float y0 = ((o[4 * r4 + 0] - mu) * rstd * gv.x + bv.x) * bf_lo(gt.x), y1 = ((o[4 * r4 + 1] - mu) * rstd * gv.y + bv.y) * bf_hi(gt.x);
        const float y2 = ((o[4 * r4 + 2] - mu) * rstd * gv.z + bv.z) * bf_lo(gt.y), y3 = ((o[4 * r4 + 3] - mu) * rstd * gv.w + bv.w) * bf_hi(gt.y);
        v2u ov; ov.x = cvtpk(y0, y1); ov.y = cvtpk(y2, y3); *(GAS v2u*)(CAT + orow * 1024 + h * 64 + e) = ov; }
}
__device__ __forceinline__ void ret_fast_phase(Frame& F, const Args& A, const int l) {
    for (int it = blockIdx.x; it < 1024; it += F.G) ret_item(F, A, l, it >> 7, (it >> 3) & 15, it & 7);
    __syncthreads();
}

#ifndef DSA_NAIVE
#define DSA_NAIVE 0
#endif
#ifndef RET_NAIVE
#define RET_NAIVE 0
#endif
#ifndef PH_MASK
#define PH_MASK 1023
#endif
template <int L> __device__ __forceinline__ void layer_phases(Frame& F, const Args& A, const XcdBarrier& bar, const int lo, const int hi) {
    constexpr int l = L, P0 = 1 + L * PH_PER_LAYER;
    unsigned char* ws = F.ws;
    bf16* ACT = (bf16*)(ws + WS_ACT);
    const float* xin = (l == 0) ? INP(IN_X) : F.out;
#define IN(k) (lo <= (k) && (k) < hi)
#define SEAM(k) do { if (IN(k) && IN((k) + 1)) xcd_barrier(bar); } while (0)
    if (IN(P0 + 0)) {
#if (PH_MASK >> 0) & 1
        pg8::Gemm g{ACT, (const bf16*)(ws + WS_WIN) + (size_t)l * NINP * DM, M, NINP, DM}; pg8::StaticOrder S; S.init(M, NINP, F.G, (int)blockIdx.x);
        pg8::EpiInProj E{(bf16*)(ws + WS_PROJ), (float*)(ws + WS_MISC), (const float*)(ws + WS_COS), (const float*)(ws + WS_SIN), M};
        pg8::gemm_phase<pg8::EpiInProj, pg8::StaticOrder, true, true>(F.lds + RING_OFF, g, S, E);
#endif
    }
    SEAM(P0 + 0);
    if (IN(P0 + 1)) {
#if (PH_MASK >> 1) & 1
#if !RET_NAIVE
        for (int c = blockIdx.x; c < 64; c += F.G) ret_state_item(F, c >> 3, c & 7);
#endif
        postproj_phase(F, A, l);
#endif
    }
    SEAM(P0 + 1);
    if (IN(P0 + 2)) {
#if (PH_MASK >> 2) & 1
#ifndef NO_RET
#if RET_NAIVE
        ret_naive_phase(F, A, l);
#else
        ret_fast_phase(F, A, l);
#endif
#endif
#ifndef NO_DSA
#if DSA_NAIVE
        dsa_naive_phase(F, A, l);
#else
        dsa_fast_phase(F, A, l);
#endif
#endif
#endif
    }
    SEAM(P0 + 2);
    if (IN(P0 + 3)) {
#if (PH_MASK >> 3) & 1
        pg8::Gemm g{(const bf16*)(ws + WS_CAT), (const bf16*)(ws + WS_WOUT) + (size_t)l * DM * DM, M, DM, DM}; pg8::StaticOrder S; S.init(M, DM, F.G, (int)blockIdx.x);
        pg8::EpiF32 E{(float*)(ws + WS_TMPD), DM};
        pg8::gemm_phase<pg8::EpiF32, pg8::StaticOrder, true, true>(F.lds + RING_OFF, g, S, E);
#endif
    }
    SEAM(P0 + 3);
    if (IN(P0 + 4)) {
#if (PH_MASK >> 4) & 1
        norm_phase(F, (const float*)(ws + WS_TMPD), xin, F.out, INP(IN_POSTMIX) + l * DM, INP(IN_PREFFN) + l * DM, ACT);
#endif
    }
    SEAM(P0 + 4);
    if (IN(P0 + 5)) {
#if (PH_MASK >> 5) & 1
        pg8::Gemm g{ACT, (const bf16*)(ws + WS_WGU) + (size_t)l * NGU * DM, M, NGU, DM}; pg8::StaticOrder S; S.init(M, NGU, F.G, (int)blockIdx.x);
        pg8::EpiSwiGLU E{(bf16*)(ws + WS_HFF), DFF};
        pg8::gemm_phase<pg8::EpiSwiGLU, pg8::StaticOrder, true, true>(F.lds + RING_OFF, g, S, E);
#endif
    }
    SEAM(P0 + 5);
    if (IN(P0 + 6)) {
#if (PH_MASK >> 6) & 1
        pg8::Gemm g{(const bf16*)(ws + WS_HFF), (const bf16*)(ws + WS_WD) + (size_t)l * DM * DFF, M, DM, DFF}; pg8::StaticOrder S; S.init(M, DM, F.G, (int)blockIdx.x);
        pg8::EpiF32 E{(float*)(ws + WS_TMPF), DM};
        pg8::gemm_phase<pg8::EpiF32, pg8::StaticOrder, true, true>(F.lds + RING_OFF, g, S, E);
#endif
    }
    SEAM(P0 + 6);
    if (IN(P0 + 7)) {
#if (PH_MASK >> 7) & 1
        norm_phase(F, (const float*)(ws + WS_TMPF), F.out, F.out, INP(IN_POSTFFN) + l * DM, nullptr, (bf16*)(ws + WS_XB));
#endif
    }
    SEAM(P0 + 7);
    if (IN(P0 + 8)) {
#if (PH_MASK >> 8) & 1
        { int Kp = PLE; asm volatile("" : "+s"(Kp));
          pg8::Gemm g{(const bf16*)(ws + WS_PB) + (size_t)l * M * PLE, (const bf16*)(ws + WS_WPU) + (size_t)l * DM * PLE, M, DM, Kp}; pg8::StaticOrder S; S.init(M, DM, F.G, (int)blockIdx.x);
          pg8::EpiBf16Plain E{(bf16*)(ws + WS_EB), DM};
          pg8::gemm_phase<pg8::EpiBf16Plain, pg8::StaticOrder, true, true>(F.lds + RING_OFF, g, S, E); }
        VM_WAIT(); __threadfence(); __syncthreads();
        { pg8::Gemm g{(const bf16*)(ws + WS_XB), (const bf16*)(ws + WS_WPG) + (size_t)l * DM * DM, M, DM, DM}; pg8::StaticOrder S; S.init(M, DM, F.G, (int)blockIdx.x);
          pg8::EpiGateMul E{(const bf16*)(ws + WS_EB), (float*)(ws + WS_TMPG), DM};
          pg8::gemm_phase<pg8::EpiGateMul, pg8::StaticOrder, true, true>(F.lds + RING_OFF, g, S, E); }
#endif
    }
    SEAM(P0 + 8);
    if (IN(P0 + 9)) {
#if (PH_MASK >> 9) & 1
        norm_phase(F, (const float*)(ws + WS_TMPG), F.out, F.out, INP(IN_PLEG) + l * DM, (l + 1 < DEPTH) ? INP(IN_PREMIX) + (l + 1) * DM : nullptr, (l + 1 < DEPTH) ? ACT : nullptr);
#endif
    }
    SEAM(P0 + 9);
#undef IN
#undef SEAM
}

__global__ void __launch_bounds__(NWAVES * 64, 2) fwd_mega(Args A) {
    extern __shared__ __attribute__((aligned(16))) unsigned char lds[];
    Frame F;
    F.lds = (LAS unsigned char*)lds;
    F.MISC = (volatile LAS unsigned*)(F.lds + MISC_OFF);
    F.tid = threadIdx.x; F.lane = F.tid & 63; F.wave = __builtin_amdgcn_readfirstlane(F.tid >> 6);
    F.G = gridDim.x;
    F.ws = A.ws; F.out = A.out; F.ctl = (gu32*)(A.ws + WS_CTL);
    for (int u = F.tid; u < (LDS_BYTES - LDSCTL_OFF) / 4; u += NWAVES * 64) ((LAS unsigned*)(F.lds + LDSCTL_OFF))[u] = 0u;
    __syncthreads();
    const int lo = A.ph_lo, hi = A.ph_hi;
    XcdBarrier bar; bar.bar = (unsigned*)(F.ctl + CW_BAR); bar.x = 0; bar.st = nullptr;
    if (hi - lo > 1) bar = xcd_barrier_post((unsigned*)(F.ctl + CW_BAR), F.MISC + 8);
#define IN(k) (lo <= (k) && (k) < hi)
#define SEAM(k) do { if (IN(k) && IN((k) + 1)) xcd_barrier(bar); } while (0)
    if (IN(0)) p0_prologue(F, A);
    SEAM(0);
    layer_phases<0>(F, A, bar, lo, hi);
    layer_phases<1>(F, A, bar, lo, hi);
}

extern "C" void kernel_launch(void* const* d_in, const int* in_sizes, int n_in, void* d_out, int out_size, void* d_ws, size_t ws_size, hipStream_t stream) {
    static int grid = 0;
    if (grid == 0) {
        if (n_in != 22 || out_size != M * DM || ws_size < WS_END) { fprintf(stderr, "kernel_launch: unexpected shapes: n_in %d out %d ws %zu\n", n_in, out_size, ws_size); grid = -1; return; }
        int dev = 0, cus = 0;
        if (hipGetDevice(&dev) != hipSuccess || hipDeviceGetAttribute(&cus, hipDeviceAttributeMultiprocessorCount, dev) != hipSuccess) { grid = -1; return; }
        if (hipFuncSetAttribute((const void*)fwd_mega, hipFuncAttributeMaxDynamicSharedMemorySize, LDS_BYTES) != hipSuccess) { fprintf(stderr, "kernel_launch: hipFuncSetAttribute failed\n"); grid = -1; return; }
        (void)hipGetLastError();
        grid = cus;
    }
    if (grid < 0) return;
    if (hipMemsetAsync((char*)d_ws + WS_CTL, 0, CTL_ZERO_BYTES, stream) != hipSuccess) return;
    Args a{};
    for (int i = 0; i < 22; ++i) a.in[i] = d_in[i];
    a.out = (float*)d_out; a.ws = (unsigned char*)d_ws;
#if MK_PER_PHASE
    for (int ph = 0; ph < NPH; ++ph) { a.ph_lo = ph; a.ph_hi = ph + 1; hipLaunchKernelGGL(fwd_mega, dim3(grid), dim3(NWAVES * 64), LDS_BYTES, stream, a); }
#else
    a.ph_lo = 0; a.ph_hi = NPH;
    hipLaunchKernelGGL(fwd_mega, dim3(grid), dim3(NWAVES * 64), LDS_BYTES, stream, a);
#endif
}
```
